# Optimizing an MI355X kernel written in HIP

```python
import jax, jax.numpy as jnp
from jax import lax
import numpy as np


D_MODEL = 1024
BATCH = 16
SEQ = 4096
DEPTH = 4

CTX_LEN = 256
GRID_W = 64
W_CONV = 512
W_FNO = 512
N_FGROUPS = 4
N_HEADS = 8
HEAD_DIM = 64
W_ATTN = N_HEADS * HEAD_DIM
WIN_H = 8
WIN_W = 16
Q_BLOCK_W = 16
K_BLOCK_W = 2 * WIN_W
N_BRANCH = 3
EPS = 1e-6
NEG_INF = -1e30
D_IN = 4 * W_CONV + 2 * W_FNO + 4 * W_ATTN + N_BRANCH * D_MODEL
KV_LO = 4 * W_CONV + 2 * W_FNO + W_ATTN
KV_HI = KV_LO + 2 * W_ATTN

kernel_name = 'hybrid_conv_fourier_natten_dit'


def rmsnorm(x, g):
    xf = x.astype(jnp.float32)
    y = xf * lax.rsqrt(jnp.mean(xf * xf, axis=-1, keepdims=True) + EPS)
    return (y * g.astype(jnp.float32)).astype(x.dtype)


def split_proj(p):
    sizes = (W_CONV,) * 4 + (W_FNO,) * 2 + (W_ATTN,) * 4 + (D_MODEL,) * N_BRANCH
    points = np.cumsum(sizes)[:-1].tolist()
    return jnp.split(p, points, axis=-1)


def heads(t):
    return t.reshape(t.shape[0], t.shape[1], N_HEADS, HEAD_DIM)


def short_conv(u, w_conv, b_conv):
    up = jnp.pad(u, ((0, 0), (1, 1), (0, 0)))
    return up[:, :-2] * w_conv[0] + up[:, 1:-1] * w_conv[1] + up[:, 2:] * w_conv[2] + b_conv


def fourier_mix(u):
    b, l, w = u.shape
    ug = u.reshape(b, l, N_FGROUPS, w // N_FGROUPS).astype(jnp.float32)
    y = jnp.fft.fft2(ug, axes=(1, 3), norm='ortho').real
    return y.reshape(b, l, w).astype(u.dtype)


def context_attention(q, k, v):
    s = jnp.einsum('bqhd,bkhd->bhqk', q, k).astype(jnp.float32) * (HEAD_DIM ** -0.5)
    p = jax.nn.softmax(s, axis=-1).astype(v.dtype)
    o = jnp.einsum('bhqk,bkhd->bqhd', p, v)
    return o.reshape(o.shape[0], o.shape[1], W_ATTN)


def neighbourhood_attention(q, k, v, k_ctx, v_ctx, rpb):
    b, s, h, dh = q.shape
    rows = s // GRID_W
    kh = min(WIN_H, rows)
    n_cb = GRID_W // Q_BLOCK_W
    scale = HEAD_DIM ** -0.5
    q = q.reshape(b, rows, n_cb, Q_BLOCK_W, h, dh)
    k = k.reshape(b, rows, GRID_W, h, dh)
    v = v.reshape(b, rows, GRID_W, h, dh)
    qcol = np.arange(GRID_W).reshape(n_cb, Q_BLOCK_W)
    kcs = np.clip(np.arange(n_cb) * Q_BLOCK_W - WIN_W // 2, 0, GRID_W - K_BLOCK_W)
    kcol = kcs[:, None] + np.arange(K_BLOCK_W)[None, :]
    cs = np.clip(qcol - WIN_W // 2, 0, GRID_W - WIN_W)
    col_ok = (kcol[:, None, :] >= cs[..., None]) & (kcol[:, None, :] < cs[..., None] + WIN_W)
    dc_idx = np.clip(kcol[:, None, :] - qcol[..., None] + WIN_W - 1, 0, 2 * WIN_W - 2)
    rpb_col = rpb[:, :, dc_idx]
    mask = col_ok[:, :, None, :]

    def row_block(r):
        rs = jnp.clip(r - kh // 2, 0, rows - kh)
        qr = lax.dynamic_index_in_dim(q, r, axis=1, keepdims=False)
        kb = lax.dynamic_slice_in_dim(k, rs, kh, axis=1)[:, :, kcol]
        vb = lax.dynamic_slice_in_dim(v, rs, kh, axis=1)[:, :, kcol]
        dr_idx = rs + jnp.arange(kh) - r + (WIN_H - 1)
        bias = jnp.take(rpb_col, dr_idx, axis=1).transpose(0, 2, 3, 1, 4).astype(jnp.float32)
        s_loc = jnp.einsum('bnqhd,binchd->bhnqic', qr, kb).astype(jnp.float32) * scale + bias
        s_loc = jnp.where(mask, s_loc, NEG_INF)
        s_ctx = jnp.einsum('bnqhd,bkhd->bhnqk', qr, k_ctx).astype(jnp.float32) * scale
        n_loc = kh * K_BLOCK_W
        sc = jnp.concatenate([s_loc.reshape(b, h, n_cb, Q_BLOCK_W, n_loc), s_ctx], axis=-1)
        p = jax.nn.softmax(sc, axis=-1).astype(v.dtype)
        p_loc = p[..., :n_loc].reshape(b, h, n_cb, Q_BLOCK_W, kh, K_BLOCK_W)
        p_ctx = p[..., n_loc:]
        return (jnp.einsum('bhnqic,binchd->bnqhd', p_loc, vb)
                + jnp.einsum('bhnqk,bkhd->bnqhd', p_ctx, v_ctx))

    o = lax.map(row_block, jnp.arange(rows))
    return o.transpose(1, 0, 2, 3, 4, 5).reshape(b, s, W_ATTN)


def merge_branches(pieces, attn_o, w_conv, b_conv, w_br_a, w_br_f, w_br_c, w_out):
    a_x, a_b, a_c, a_z, f_u, f_z, _q, _k, _v, c_z, g_a, g_f, g_c = pieces
    silu, sig = jax.nn.silu, jax.nn.sigmoid
    y_a = (a_b * short_conv(a_c * a_x, w_conv, b_conv) * silu(a_z)) @ w_br_a
    y_f = (fourier_mix(f_u) * silu(f_z)) @ w_br_f
    y_c = (attn_o * silu(c_z)) @ w_br_c
    return (sig(g_a) * y_a + sig(g_f) * y_f + sig(g_c) * y_c) @ w_out


def hybrid_layer(x, ctx, c, c_ctx, norm_g, w_ada, b_ada, w_in, b_in, w_conv, b_conv,
                 rpb, w_br_a, w_br_f, w_br_c, w_out, update_ctx):
    mod_l = jax.nn.silu(c) @ w_ada + b_ada
    mod_c = jax.nn.silu(c_ctx) @ w_ada + b_ada
    sh_l, sc_l, gt_l = jnp.split(mod_l[:, None, :], 3, axis=-1)
    sh_c, sc_c, gt_c = jnp.split(mod_c, 3, axis=-1)
    h_lat = rmsnorm(x, norm_g) * (1.0 + sc_l) + sh_l
    h_ctx = rmsnorm(ctx, norm_g) * (1.0 + sc_c) + sh_c

    pl = split_proj(h_lat @ w_in + b_in)
    if update_ctx:
        pc = split_proj(h_ctx @ w_in + b_in)
        k_c, v_c = pc[7], pc[8]
    else:
        k_c, v_c = jnp.split(h_ctx @ w_in[:, KV_LO:KV_HI] + b_in[KV_LO:KV_HI], 2, axis=-1)
    k_c, v_c = heads(k_c), heads(v_c)

    o_lat = neighbourhood_attention(heads(pl[6]), heads(pl[7]), heads(pl[8]), k_c, v_c, rpb)
    x_new = x + gt_l * merge_branches(pl, o_lat, w_conv, b_conv, w_br_a, w_br_f, w_br_c, w_out)
    if update_ctx:
        o_ctx = context_attention(heads(pc[6]), k_c, v_c)
        ctx = ctx + gt_c * merge_branches(pc, o_ctx, w_conv, b_conv, w_br_a, w_br_f, w_br_c, w_out)
    return x_new, ctx


def setup_inputs(seed: int = 0) -> dict:
    key = jax.random.key(seed)
    ks = jax.random.split(key, 17)
    f32 = jnp.float32
    nrm = lambda k, shape, s: jax.random.normal(k, shape, f32) * s
    return {
        'x': nrm(ks[0], (BATCH, SEQ, D_MODEL), 1.0),
        'c': nrm(ks[1], (BATCH, D_MODEL), 1.0),
        'ctx': nrm(ks[2], (BATCH, CTX_LEN, D_MODEL), 1.0),
        'c_ctx': nrm(ks[3], (D_MODEL,), 1.0),
        'norm_g': 1.0 + nrm(ks[4], (DEPTH, D_MODEL), 0.05),
        'w_ada': nrm(ks[5], (DEPTH, D_MODEL, 3 * D_MODEL), 0.5 * D_MODEL ** -0.5),
        'b_ada': nrm(ks[6], (DEPTH, 3 * D_MODEL), 0.01),
        'w_in': nrm(ks[7], (DEPTH, D_MODEL, D_IN), D_MODEL ** -0.5),
        'b_in': nrm(ks[8], (DEPTH, D_IN), 0.01),
        'w_conv': nrm(ks[9], (DEPTH, 3, W_CONV), 3 ** -0.5),
        'b_conv': nrm(ks[10], (DEPTH, W_CONV), 0.01),
        'rpb': nrm(ks[11], (DEPTH, N_HEADS, 2 * WIN_H - 1, 2 * WIN_W - 1), 0.1),
        'w_br_a': nrm(ks[12], (DEPTH, W_CONV, D_MODEL), W_CONV ** -0.5),
        'w_br_f': nrm(ks[13], (DEPTH, W_FNO, D_MODEL), W_FNO ** -0.5),
        'w_br_c': nrm(ks[14], (DEPTH, W_ATTN, D_MODEL), W_ATTN ** -0.5),
        'w_out': nrm(ks[15], (DEPTH, D_MODEL, D_MODEL), D_MODEL ** -0.5),
        'final_g': 1.0 + nrm(ks[16], (D_MODEL,), 0.05),
    }


def reference(x, c, ctx, c_ctx, norm_g, w_ada, b_ada, w_in, b_in, w_conv, b_conv,
              rpb, w_br_a, w_br_f, w_br_c, w_out, final_g):
    for l in range(DEPTH):
        x, ctx = hybrid_layer(x, ctx, c, c_ctx, norm_g[l], w_ada[l], b_ada[l], w_in[l], b_in[l],
                              w_conv[l], b_conv[l], rpb[l], w_br_a[l], w_br_f[l], w_br_c[l],
                              w_out[l], update_ctx=(l < DEPTH - 1))
    return rmsnorm(x, final_g)
```

```cpp
#include <hip/hip_runtime.h>
#include <hip/hip_cooperative_groups.h>
#include <cstdio>
namespace cg = cooperative_groups;

#define LAS __attribute__((address_space(3)))
typedef _Float16 h16;
typedef _Float16 h8 __attribute__((ext_vector_type(8)));
typedef _Float16 h4 __attribute__((ext_vector_type(4)));
typedef float f32x4 __attribute__((ext_vector_type(4)));

#ifndef MULTI_LAUNCH
#define MULTI_LAUNCH 0
#endif

constexpr int DM = 1024, NBATCH = 16, SEQ = 4096, DEPTH = 4, CTXL = 256, DIN = 8192;
constexpr int BC = 8, NCH = 2;
constexpr int TL = BC * SEQ, TX = BC * CTXL, TC = TL + TX;
constexpr int NIN = 8704;
constexpr int NTHREADS = 512;
constexpr int LDS_STAGE = 131072, LDS_BYTES = LDS_STAGE + 16384;

constexpr size_t al256(size_t x) { return (x + 255) & ~(size_t)255; }
constexpr size_t OFF_WIN = 0;
constexpr size_t OFF_BIN = al256(OFF_WIN + (size_t)DEPTH * NIN * 1024 * 2);
constexpr size_t OFF_WBR = al256(OFF_BIN + (size_t)DEPTH * NIN * 4);
constexpr size_t OFF_WOUT = al256(OFF_WBR + (size_t)DEPTH * 3 * 1024 * 512 * 2);
constexpr size_t OFF_CS = al256(OFF_WOUT + (size_t)DEPTH * 1024 * 1024 * 2);
constexpr size_t OFF_CS2 = al256(OFF_CS + (size_t)4096 * 8192 * 2);
constexpr size_t OFF_MOD = al256(OFF_CS2 + (size_t)256 * 512 * 2);
constexpr size_t OFF_CTXR = al256(OFF_MOD + (size_t)DEPTH * 17 * 3072 * 4);
constexpr size_t OFF_H = al256(OFF_CTXR + (size_t)NBATCH * CTXL * 1024 * 4);
constexpr size_t OFF_M = al256(OFF_H + (size_t)TC * 1024 * 2);
constexpr size_t SZ512 = (size_t)TC * 512 * 2;
constexpr size_t OFF_CX = al256(OFF_M + (size_t)TC * 1024 * 2);
constexpr size_t OFF_BZ = al256(OFF_CX + SZ512);
constexpr size_t OFF_FZ = al256(OFF_BZ + SZ512);
constexpr size_t OFF_Q = al256(OFF_FZ + SZ512);
constexpr size_t OFF_K = al256(OFF_Q + SZ512);
constexpr size_t OFF_CZ = al256(OFF_K + SZ512);
constexpr size_t OFF_AACT = al256(OFF_CZ + SZ512);
constexpr size_t OFF_G = al256(OFF_AACT + SZ512);
constexpr size_t OFF_VTL = al256(OFF_G + (size_t)TC * 3072 * 2);
constexpr size_t OFF_VTC = al256(OFF_VTL + (size_t)BC * 512 * 8192 * 2);
constexpr size_t OFF_VVL = al256(OFF_VTC + (size_t)BC * 512 * 512 * 2);
constexpr size_t OFF_VVC = al256(OFF_VVL + (size_t)BC * 512 * 4096 * 2);
constexpr size_t WS_END = al256(OFF_VVC + (size_t)BC * 512 * 256 * 2);

struct Params {
    const float *x, *c, *ctx, *c_ctx, *norm_g, *w_ada, *b_ada, *w_in, *b_in, *w_conv, *b_conv, *rpb, *w_br_a, *w_br_f, *w_br_c, *w_out, *final_g;
    float* out; unsigned char* ws; int ph_lo, ph_hi;
};

__device__ __forceinline__ float silu_f(float v) { return v * __builtin_amdgcn_rcpf(1.f + __expf(-v)); }
__device__ __forceinline__ float sigm_f(float v) { return __builtin_amdgcn_rcpf(1.f + __expf(-v)); }

__device__ __forceinline__ int in_col(int n) {
    const int j = n >> 8, w = n & 255;
    if (j < 4) return (w < 128) ? (128 * j + w) : (1024 + 128 * j + (w - 128));
    if (j < 8) return (w < 128) ? (512 + 128 * (j - 4) + w) : (1536 + 128 * (j - 4) + (w - 128));
    if (j < 10) return 2560 + (j - 8) * 256 + w;
    if (j < 12) return 3072 + (j - 10) * 256 + w;
    if (j < 14) return 3584 + (j - 12) * 256 + w;
    if (j < 16) return 4608 + (j - 14) * 256 + w;
    if (j < 28) return 5120 + (j - 16) * 256 + w;
    return 4096 + (n - 7168);
}

template <bool PERMCOL>
__device__ __forceinline__ void transpose_tile(const int tid, const float* __restrict__ src, int lds_, h16* __restrict__ dst, int ldd, int k0, int n0, LAS float* t) {
    const int a = tid & 63, b = tid >> 6;
    const int col = PERMCOL ? in_col(n0 + a) : (n0 + a);
#pragma unroll
    for (int it = 0; it < 8; ++it) { const int k = b + it * 8; t[k * 65 + a] = src[(size_t)(k0 + k) * lds_ + col]; }
    __syncthreads();
#pragma unroll
    for (int it = 0; it < 8; ++it) { const int n = b + it * 8; dst[(size_t)(n0 + n) * ldd + k0 + a] = (h16)t[a * 65 + n]; }
    __syncthreads();
}

__device__ __forceinline__ void p0_prologue(const Params& p, LAS unsigned char* lds, const int tid, const int bid) {
    const int G = gridDim.x;
    unsigned char* ws = p.ws;
    LAS float* lf = (LAS float*)lds;
    constexpr int N_MOD = DEPTH * 24;
    constexpr int N_TIN = DEPTH * 120 * 16;
    constexpr int N_FOU = DEPTH * 1024;
    constexpr int N_BIAS = DEPTH;
    constexpr int N_TBR = DEPTH * 3 * 16 * 8;
    constexpr int N_TOUT = DEPTH * 16 * 16;
    constexpr int N_CS = 8192;
    constexpr int N_CS2 = 32;
    constexpr int E0 = N_MOD, E1 = E0 + N_TIN, E2 = E1 + N_FOU, E3 = E2 + N_BIAS, E4 = E3 + N_TBR, E5 = E4 + N_TOUT, E6 = E5 + N_CS, E7 = E6 + N_CS2;
    for (int it = bid; it < E7; it += G) {
        if (it < E0) {
            const int l = it / 24, cb = it % 24;
            for (int i = tid; i < 17 * 1024; i += NTHREADS) { const float v = (i < 16 * 1024) ? p.c[i] : p.c_ctx[i - 16 * 1024]; lf[i] = silu_f(v); }
            __syncthreads();
            const int col = cb * 128 + (tid & 127), kq = tid >> 7;
            float acc[17];
#pragma unroll
            for (int j = 0; j < 17; ++j) acc[j] = 0.f;
            const float* wp = p.w_ada + (size_t)l * 1024 * 3072 + col;
            for (int k = kq * 256; k < kq * 256 + 256; ++k) {
                const float w = wp[(size_t)k * 3072];
#pragma unroll
                for (int j = 0; j < 17; ++j) acc[j] += lf[j * 1024 + k] * w;
            }
            LAS float* red = lf + 17 * 1024;
#pragma unroll
            for (int j = 0; j < 17; ++j) red[(kq * 17 + j) * 128 + (tid & 127)] = acc[j];
            __syncthreads();
            float* MOD = (float*)(ws + OFF_MOD);
            for (int i = tid; i < 17 * 128; i += NTHREADS) {
                const int j = i >> 7, cc = i & 127;
                const float s = red[(0 * 17 + j) * 128 + cc] + red[(1 * 17 + j) * 128 + cc] + red[(2 * 17 + j) * 128 + cc] + red[(3 * 17 + j) * 128 + cc];
                MOD[((size_t)l * 17 + j) * 3072 + cb * 128 + cc] = s + p.b_ada[l * 3072 + cb * 128 + cc];
            }
            __syncthreads();
        } else if (it < E1) {
            const int t = it - E0, l = t / (120 * 16), r = t % (120 * 16), nt = r / 16, kt = r % 16;
            transpose_tile<true>(tid, p.w_in + (size_t)l * 1024 * DIN, DIN, (h16*)(ws + OFF_WIN) + (size_t)l * NIN * 1024, 1024, kt * 64, nt * 64, lf);
        } else if (it < E2) {
            const int t = it - E1, l = t >> 10, k = t & 1023;
            lf[tid] = p.w_in[((size_t)l * 1024 + k) * DIN + 2048 + tid];
            if (tid < 128) { lf[512 + tid] = cospif((float)tid * (1.f / 64.f)); lf[640 + tid] = sinpif((float)tid * (1.f / 64.f)); }
            __syncthreads();
            const int g = tid >> 7, kk = tid & 127;
            float re = 0.f, im = 0.f;
            for (int n2 = 0; n2 < 128; ++n2) { const float w = lf[g * 128 + n2]; const int ix = (n2 * kk) & 127; re += w * lf[512 + ix]; im -= w * lf[640 + ix]; }
            h16* W = (h16*)(ws + OFF_WIN) + (size_t)l * NIN * 1024;
            W[(size_t)(7680 + tid) * 1024 + k] = (h16)(re * 0.08838834764831845f);
            W[(size_t)(7680 + 512 + tid) * 1024 + k] = (h16)(im * 0.08838834764831845f);
            __syncthreads();
        } else if (it < E3) {
            const int l = it - E2;
            float* B = (float*)(ws + OFF_BIN) + (size_t)l * NIN;
            const float* bi = p.b_in + (size_t)l * DIN;
            for (int n = tid; n < 7680; n += NTHREADS) B[n] = bi[in_col(n)];
            const int g = tid >> 7, kk = tid & 127;
            float re = 0.f, im = 0.f;
            for (int n2 = 0; n2 < 128; ++n2) { const float w = bi[2048 + g * 128 + n2]; const float ang = (float)((n2 * kk) & 127) * (1.f / 64.f); re += w * cospif(ang); im -= w * sinpif(ang); }
            B[7680 + tid] = re * 0.08838834764831845f; B[7680 + 512 + tid] = im * 0.08838834764831845f;
        } else if (it < E4) {
            const int t = it - E3, lb = t / 128, r = t % 128, nt = r / 8, kt = r % 8, l = lb / 3, br = lb % 3;
            const float* src = (br == 0 ? p.w_br_a : (br == 1 ? p.w_br_f : p.w_br_c)) + (size_t)l * 512 * 1024;
            transpose_tile<false>(tid, src, 1024, (h16*)(ws + OFF_WBR) + (size_t)lb * 1024 * 512, 512, kt * 64, nt * 64, lf);
        } else if (it < E5) {
            const int t = it - E4, l = t / 256, r = t % 256, nt = r / 16, kt = r % 16;
            transpose_tile<false>(tid, p.w_out + (size_t)l * 1024 * 1024, 1024, (h16*)(ws + OFF_WOUT) + (size_t)l * 1024 * 1024, 1024, kt * 64, nt * 64, lf);
        } else if (it < E6) {
            const size_t e0 = ((size_t)(it - E5) * NTHREADS + tid) * 8;
            const int k1 = (int)(e0 >> 13), j0 = (int)(e0 & 8191);
            h8 o;
#pragma unroll
            for (int j = 0; j < 8; ++j) { const int jj = j0 + j, pos = jj & 4095; const float ang = (float)((k1 * pos) & 4095) * (1.f / 2048.f); o[j] = (h16)((jj < 4096) ? cospif(ang) : sinpif(ang)); }
            *(h8*)((h16*)(ws + OFF_CS) + e0) = o;
        } else {
            const size_t e0 = ((size_t)(it - E6) * NTHREADS + tid) * 8;
            const int k1 = (int)(e0 >> 9), j0 = (int)(e0 & 511);
            h8 o;
#pragma unroll
            for (int j = 0; j < 8; ++j) { const int jj = j0 + j, pos = jj & 255; const float ang = (float)((k1 * pos) & 255) * (1.f / 128.f); o[j] = (h16)((jj < 256) ? cospif(ang) : sinpif(ang)); }
            *(h8*)((h16*)(ws + OFF_CS2) + e0) = o;
        }
    }
}

__device__ __forceinline__ void p1_norm(const Params& p, int l, int ch, const int tid, const int bid) {
    const int lane = tid & 63, wid = tid >> 6;
    unsigned char* ws = p.ws;
    const float* xsrc = (l == 0) ? p.x : p.out;
    const float* csrc = (l == 0) ? p.ctx : (const float*)(ws + OFF_CTXR);
    const float* MOD = (const float*)(ws + OFF_MOD) + (size_t)l * 17 * 3072;
    const float* ng = p.norm_g + l * 1024;
    h16* H = (h16*)(ws + OFF_H);
    for (int row = bid * 8 + wid; row < TC; row += gridDim.x * 8) {
        const float* src = (row < TL) ? xsrc + ((size_t)ch * TL + row) * 1024 : csrc + ((size_t)ch * TX + (row - TL)) * 1024;
        const float* mod = MOD + (size_t)((row < TL) ? (ch * BC + (row >> 12)) : 16) * 3072;
        f32x4 v[4]; float ss = 0.f;
#pragma unroll
        for (int it = 0; it < 4; ++it) { v[it] = *(const f32x4*)(src + it * 256 + lane * 4); ss += v[it][0] * v[it][0] + v[it][1] * v[it][1] + v[it][2] * v[it][2] + v[it][3] * v[it][3]; }
#pragma unroll
        for (int o = 32; o >= 1; o >>= 1) ss += __shfl_xor(ss, o);
        const float inv = rsqrtf(ss * (1.f / 1024.f) + 1e-6f);
#pragma unroll
        for (int it = 0; it < 4; ++it) {
            const int c = it * 256 + lane * 4;
            const f32x4 g = *(const f32x4*)(ng + c), sh = *(const f32x4*)(mod + c), sc = *(const f32x4*)(mod + 1024 + c);
            h4 o;
#pragma unroll
            for (int j = 0; j < 4; ++j) o[j] = (h16)(v[it][j] * inv * g[j] * (1.f + sc[j]) + sh[j]);
            *(h4*)(H + (size_t)row * 1024 + c) = o;
        }
    }
}

__device__ __forceinline__ void pf_final(const Params& p, const int tid, const int bid) {
    const int lane = tid & 63, wid = tid >> 6;
    for (int row = bid * 8 + wid; row < NBATCH * SEQ; row += gridDim.x * 8) {
        float* src = p.out + (size_t)row * 1024;
        f32x4 v[4]; float ss = 0.f;
#pragma unroll
        for (int it = 0; it < 4; ++it) { v[it] = *(const f32x4*)(src + it * 256 + lane * 4); ss += v[it][0] * v[it][0] + v[it][1] * v[it][1] + v[it][2] * v[it][2] + v[it][3] * v[it][3]; }
#pragma unroll
        for (int o = 32; o >= 1; o >>= 1) ss += __shfl_xor(ss, o);
        const float inv = rsqrtf(ss * (1.f / 1024.f) + 1e-6f);
#pragma unroll
        for (int it = 0; it < 4; ++it) { const int c = it * 256 + lane * 4; const f32x4 g = *(const f32x4*)(p.final_g + c); *(f32x4*)(src + c) = v[it] * inv * g; }
    }
}

__device__ __forceinline__ void p3_conv(const Params& p, int l, const int tid, const int bid) {
    unsigned char* ws = p.ws;
    const h16* CX = (const h16*)(ws + OFF_CX); const h16* BZ = (const h16*)(ws + OFF_BZ); h16* AA = (h16*)(ws + OFF_AACT);
    const float* wc = p.w_conv + (size_t)l * 3 * 512; const float* bc = p.b_conv + (size_t)l * 512;
    const int nrows = (l == DEPTH - 1) ? TL : TC;
    for (int idx = bid * NTHREADS + tid; idx < nrows * 64; idx += gridDim.x * NTHREADS) {
        const int row = idx >> 6, c8 = (idx & 63) * 8;
        const int pos = (row < TL) ? (row & 4095) : ((row - TL) & 255), L = (row < TL) ? 4096 : 256;
        const h8 z = {0, 0, 0, 0, 0, 0, 0, 0};
        const h8 cur = *(const h8*)(CX + (size_t)row * 512 + c8);
        const h8 prv = (pos > 0) ? *(const h8*)(CX + (size_t)(row - 1) * 512 + c8) : z;
        const h8 nxt = (pos < L - 1) ? *(const h8*)(CX + (size_t)(row + 1) * 512 + c8) : z;
        const h8 bz = *(const h8*)(BZ + (size_t)row * 512 + c8);
        h8 o;
#pragma unroll
        for (int j = 0; j < 8; ++j) {
            const float cv = wc[c8 + j] * (float)prv[j] + wc[512 + c8 + j] * (float)cur[j] + wc[1024 + c8 + j] * (float)nxt[j] + bc[c8 + j];
            o[j] = (h16)((float)bz[j] * cv);
        }
        *(h8*)(AA + (size_t)row * 512 + c8) = o;
    }
}

__device__ __forceinline__ void p3_attn(const Params& p, int l, LAS float* rpbL, const int tid, const int bid) {
    const int lane = tid & 63, wid = tid >> 6, fr = lane & 15, fq = lane >> 4;
    unsigned char* ws = p.ws;
    const h16* Qb = (const h16*)(ws + OFF_Q); const h16* Kb = (const h16*)(ws + OFF_K);
    const h16* VVL = (const h16*)(ws + OFF_VVL); const h16* VVC = (const h16*)(ws + OFF_VVC);
    h16* CZ = (h16*)(ws + OFF_CZ);
    for (int i = tid; i < 8 * 15 * 31; i += NTHREADS) rpbL[i] = p.rpb[(size_t)l * 8 * 15 * 31 + i];
    __syncthreads();
    const f32x4 zero4 = {0.f, 0.f, 0.f, 0.f};
    for (int u = bid * 8 + wid; u < BC * 8 * 64 * 4; u += gridDim.x * 8) {
        const int n = u & 3, r = (u >> 2) & 63, h = (u >> 8) & 7, bb = u >> 11;
        const int tokQ = bb * 4096 + r * 64 + n * 16 + fr;
        const h16* qp = Qb + (size_t)tokQ * 512 + h * 64 + fq * 8;
        const h8 q0 = *(const h8*)qp, q1 = *(const h8*)(qp + 32);
        int kcs = n * 16 - 8; kcs = kcs < 0 ? 0 : (kcs > 32 ? 32 : kcs);
        int rs = r - 4; rs = rs < 0 ? 0 : (rs > 56 ? 56 : rs);
        const int qcol = n * 16 + fr; int cs = qcol - 8; cs = cs < 0 ? 0 : (cs > 48 ? 48 : cs);
        f32x4 s[32];
#pragma unroll
        for (int t = 0; t < 16; ++t) {
            const int i = t >> 1, par = t & 1;
            const int keytok = bb * 4096 + (rs + i) * 64 + kcs + 16 * par + fr;
            const h16* kp = Kb + (size_t)keytok * 512 + h * 64 + fq * 8;
            const h8 k0 = *(const h8*)kp, k1 = *(const h8*)(kp + 32);
            f32x4 a = zero4;
            a = __builtin_amdgcn_mfma_f32_16x16x32_f16(k0, q0, a, 0, 0, 0);
            a = __builtin_amdgcn_mfma_f32_16x16x32_f16(k1, q1, a, 0, 0, 0);
            const int kc0 = kcs + 16 * par + 4 * fq;
            const LAS float* bp = rpbL + (h * 15 + (rs + i - r + 7)) * 31;
#pragma unroll
            for (int j = 0; j < 4; ++j) {
                const int kcol = kc0 + j; const bool ok = (kcol >= cs) && (kcol < cs + 16);
                int dc = kcol - qcol + 15; dc = dc < 0 ? 0 : (dc > 30 ? 30 : dc);
                a[j] = ok ? a[j] + bp[dc] : -1e30f;
            }
            s[t] = a;
            if ((t & 3) == 3) asm volatile("" ::: "memory");
        }
#pragma unroll
        for (int t = 16; t < 32; ++t) {
            const int keytok = TL + bb * 256 + (t - 16) * 16 + fr;
            const h16* kp = Kb + (size_t)keytok * 512 + h * 64 + fq * 8;
            const h8 k0 = *(const h8*)kp, k1 = *(const h8*)(kp + 32);
            f32x4 a = zero4;
            a = __builtin_amdgcn_mfma_f32_16x16x32_f16(k0, q0, a, 0, 0, 0);
            a = __builtin_amdgcn_mfma_f32_16x16x32_f16(k1, q1, a, 0, 0, 0);
            s[t] = a;
            if ((t & 3) == 3) asm volatile("" ::: "memory");
        }
        float mx = -3e38f;
#pragma unroll
        for (int t = 0; t < 32; ++t) mx = fmaxf(mx, fmaxf(fmaxf(s[t][0], s[t][1]), fmaxf(s[t][2], s[t][3])));
        mx = fmaxf(mx, __shfl_xor(mx, 16)); mx = fmaxf(mx, __shfl_xor(mx, 32));
        float sum = 0.f;
#pragma unroll
        for (int t = 0; t < 32; ++t) {
#pragma unroll
            for (int j = 0; j < 4; ++j) { const float e = __expf(s[t][j] - mx); s[t][j] = e; sum += e; }
        }
        sum += __shfl_xor(sum, 16); sum += __shfl_xor(sum, 32);
        f32x4 o[4] = {zero4, zero4, zero4, zero4};
#pragma unroll
        for (int tp = 0; tp < 16; ++tp) {
            h8 pf;
#pragma unroll
            for (int j = 0; j < 4; ++j) { pf[j] = (h16)s[2 * tp][j]; pf[4 + j] = (h16)s[2 * tp + 1][j]; }
#pragma unroll
            for (int dt = 0; dt < 4; ++dt) {
                const h16* vp = (tp < 8) ? VVL + ((size_t)(bb * 512 + h * 64 + 16 * dt + fr)) * 4096 + (rs + tp) * 64 + kcs + 4 * fq
                                         : VVC + ((size_t)(bb * 512 + h * 64 + 16 * dt + fr)) * 256 + (2 * tp - 16) * 16 + 4 * fq;
                const h4 v0 = *(const h4*)vp, v1 = *(const h4*)(vp + 16);
                const h8 vf = {v0[0], v0[1], v0[2], v0[3], v1[0], v1[1], v1[2], v1[3]};
                o[dt] = __builtin_amdgcn_mfma_f32_16x16x32_f16(vf, pf, o[dt], 0, 0, 0);
            }
            if ((tp & 1) == 1) asm volatile("" ::: "memory");
        }
        const float inv = 1.f / sum;
#pragma unroll
        for (int dt = 0; dt < 4; ++dt) {
            h16* cp = CZ + (size_t)tokQ * 512 + h * 64 + 16 * dt + 4 * fq;
            const h4 cz = *(const h4*)cp; h4 ov;
#pragma unroll
            for (int j = 0; j < 4; ++j) ov[j] = (h16)(o[dt][j] * inv * (float)cz[j]);
            *(h4*)cp = ov;
        }
    }
    if (l < DEPTH - 1) {
        for (int u = bid * 8 + wid; u < BC * 8 * 16; u += gridDim.x * 8) {
            const int qg = u & 15, h = (u >> 4) & 7, bb = u >> 7;
            const int tokQ = TL + bb * 256 + qg * 16 + fr;
            const h16* qp = Qb + (size_t)tokQ * 512 + h * 64 + fq * 8;
            const h8 q0 = *(const h8*)qp, q1 = *(const h8*)(qp + 32);
            f32x4 s[16];
#pragma unroll
            for (int t = 0; t < 16; ++t) {
                const int keytok = TL + bb * 256 + t * 16 + fr;
                const h16* kp = Kb + (size_t)keytok * 512 + h * 64 + fq * 8;
                const h8 k0 = *(const h8*)kp, k1 = *(const h8*)(kp + 32);
                f32x4 a = zero4;
                a = __builtin_amdgcn_mfma_f32_16x16x32_f16(k0, q0, a, 0, 0, 0);
                a = __builtin_amdgcn_mfma_f32_16x16x32_f16(k1, q1, a, 0, 0, 0);
                s[t] = a;
            }
            float mx = -3e38f;
#pragma unroll
            for (int t = 0; t < 16; ++t) mx = fmaxf(mx, fmaxf(fmaxf(s[t][0], s[t][1]), fmaxf(s[t][2], s[t][3])));
            mx = fmaxf(mx, __shfl_xor(mx, 16)); mx = fmaxf(mx, __shfl_xor(mx, 32));
            float sum = 0.f;
#pragma unroll
            for (int t = 0; t < 16; ++t) {
#pragma unroll
                for (int j = 0; j < 4; ++j) { const float e = __expf(s[t][j] - mx); s[t][j] = e; sum += e; }
            }
            sum += __shfl_xor(sum, 16); sum += __shfl_xor(sum, 32);
            f32x4 o[4] = {zero4, zero4, zero4, zero4};
#pragma unroll
            for (int tp = 0; tp < 8; ++tp) {
                h8 pf;
#pragma unroll
                for (int j = 0; j < 4; ++j) { pf[j] = (h16)s[2 * tp][j]; pf[4 + j] = (h16)s[2 * tp + 1][j]; }
#pragma unroll
                for (int dt = 0; dt < 4; ++dt) {
                    const h16* vp = VVC + ((size_t)(bb * 512 + h * 64 + 16 * dt + fr)) * 256 + (2 * tp) * 16 + 4 * fq;
                    const h4 v0 = *(const h4*)vp, v1 = *(const h4*)(vp + 16);
                    const h8 vf = {v0[0], v0[1], v0[2], v0[3], v1[0], v1[1], v1[2], v1[3]};
                    o[dt] = __builtin_amdgcn_mfma_f32_16x16x32_f16(vf, pf, o[dt], 0, 0, 0);
                }
            }
            const float inv = 1.f / sum;
#pragma unroll
            for (int dt = 0; dt < 4; ++dt) {
                h16* cp = CZ + (size_t)tokQ * 512 + h * 64 + 16 * dt + 4 * fq;
                const h4 cz = *(const h4*)cp; h4 ov;
#pragma unroll
                for (int j = 0; j < 4; ++j) ov[j] = (h16)(o[dt][j] * inv * (float)cz[j]);
                *(h4*)cp = ov;
            }
        }
    }
}

constexpr int BM = 256, BK = 64, HALF = 128, HTB = HALF * BK * 2;
enum { K_IN = 0, K_DFT = 1, K_CDFT = 2, K_MERGE = 3, K_OUT = 4 };
struct Unit { const char* A; const char* B; int pm, pn, aux; };

__device__ __forceinline__ int lds_byte(int r, int c) { const int st = (r >> 4) * 2 + (c >> 5), rr = r & 15, cc = c & 31, ob = rr * 64 + cc * 2; return st * 1024 + (ob ^ (((ob >> 9) & 1) << 5)); }
__device__ __forceinline__ void stage_rc(int b, int& R, int& C) { const int st = b / 1024, sb = b % 1024, swz = sb ^ (((sb >> 9) & 1) << 5); R = (st >> 1) * 16 + swz / 64; C = (st & 1) * 32 + (swz % 64) / 2; }
__device__ __forceinline__ int perm32(int rho) { const int n = rho >> 4, i = rho & 15; return 8 * (i >> 2) + 4 * n + (i & 3); }

__device__ __forceinline__ bool sched_next(const Params& p, const int kind, const int l, const int i, Unit& u, const int bid) {
    const int G = gridDim.x, c = bid;
    const char* ws = (const char*)p.ws;
    if (kind == K_IN) {
        constexpr int nM = TC / 256, nN = NIN / 256, nwg = nM * nN;
        const long L = (long)i * G + c; if (L >= nwg) return false;
        int wgid = (int)L; { const int q = nwg / 8, r = nwg % 8, xcd = wgid % 8, off = wgid / 8; wgid = (xcd < r ? xcd * (q + 1) : r * (q + 1) + (xcd - r) * q) + off; }
        const int nig = 8 * nN, gid = wgid / nig, fm = gid * 8, gsz = (nM - fm) < 8 ? (nM - fm) : 8;
        const int pm = fm + ((wgid % nig) % gsz), pn = (wgid % nig) / gsz;
        const char* Hp = ws + OFF_H + (size_t)pm * 256 * 1024 * 2;
        const char* Wp = ws + OFF_WIN + ((size_t)l * NIN + pn * 256) * 1024 * 2;
        if (pn < 28) { u.A = Hp; u.B = Wp; } else { u.A = Wp; u.B = Hp; }
        u.pm = pm; u.pn = pn; u.aux = 0; return true;
    } else if (kind == K_DFT) {
        const int L = i * G + c; if (L >= BC * 32) return false;
        const int bb = L & 7, j = L >> 3, pm = j >> 1, pn = j & 1;
        u.A = ws + OFF_CS + (size_t)pm * 256 * 8192 * 2; u.B = ws + OFF_VTL + ((size_t)(bb * 512 + pn * 256)) * 8192 * 2;
        u.pm = pm; u.pn = pn; u.aux = bb; return true;
    } else if (kind == K_CDFT) {
        const int L = i * G + c; if (L >= BC * 2) return false;
        const int bb = L >> 1, pn = L & 1;
        u.A = ws + OFF_CS2; u.B = ws + OFF_VTC + ((size_t)(bb * 512 + pn * 256)) * 512 * 2;
        u.pm = 0; u.pn = pn; u.aux = bb; return true;
    } else if (kind == K_MERGE) {
        const int ntile = ((l == DEPTH - 1) ? TL / 256 : TC / 256) * 4;
        const int ti = (i / 3) * G + c, br = i % 3; if (ti >= ntile) return false;
        const int pm = ti >> 2, pn = ti & 3;
        const size_t aoff = (br == 0) ? OFF_AACT : (br == 1 ? OFF_FZ : OFF_CZ);
        u.A = ws + aoff + (size_t)pm * 256 * 512 * 2; u.B = ws + OFF_WBR + ((size_t)((l * 3 + br) * 1024 + pn * 256)) * 512 * 2;
        u.pm = pm; u.pn = pn; u.aux = br; return true;
    } else {
        const int ntile = ((l == DEPTH - 1) ? TL / 256 : TC / 256) * 4;
        const int ti = i * G + c; if (ti >= ntile) return false;
        const int pm = ti >> 2, pn = ti & 3;
        u.A = ws + OFF_M + (size_t)pm * 256 * 1024 * 2; u.B = ws + OFF_WOUT + ((size_t)(l * 1024 + pn * 256)) * 1024 * 2;
        u.pm = pm; u.pn = pn; u.aux = 0; return true;
    }
}

__device__ __forceinline__ void epilogue(const Params& p, const int kind, const int l, const int ch, const Unit& u, const f32x4 (&acc)[2][2][4][2], int wr, int wc, int fr, int fq) {
    unsigned char* ws = p.ws;
    const int cw = wc * 32 + 8 * fq, rl0 = wr * 64 + fr;
    const int pm = u.pm, pn = u.pn;
    if (kind == K_IN) {
        const float* bias = (const float*)(ws + OFF_BIN) + (size_t)l * NIN + pn * 256;
        if (pn < 8) {
            f32x4 b[2][2];
#pragma unroll
            for (int bj = 0; bj < 2; ++bj)
#pragma unroll
                for (int n = 0; n < 2; ++n) b[bj][n] = *(const f32x4*)(bias + 128 * bj + cw + 4 * n);
            h16* dst = (h16*)(ws + (pn < 4 ? OFF_CX : OFF_BZ)) + (size_t)(pm * 256 + rl0) * 512 + 128 * (pn & 3) + cw;
            const bool mul = pn < 4;
#pragma unroll
            for (int ai = 0; ai < 2; ++ai)
#pragma unroll
                for (int m = 0; m < 4; ++m) {
                    h8 o;
#pragma unroll
                    for (int n = 0; n < 2; ++n)
#pragma unroll
                        for (int j = 0; j < 4; ++j) {
                            const float v0 = acc[ai][0][m][n][j] + b[0][n][j], v1 = acc[ai][1][m][n][j] + b[1][n][j];
                            o[4 * n + j] = (h16)(mul ? v0 * v1 : v0 * silu_f(v1));
                        }
                    *(h8*)(dst + (size_t)(128 * ai + 16 * m) * 512) = o;
                }
        } else if (pn < 28) {
            f32x4 b[2][2];
#pragma unroll
            for (int bj = 0; bj < 2; ++bj)
#pragma unroll
                for (int n = 0; n < 2; ++n) b[bj][n] = *(const f32x4*)(bias + 128 * bj + cw + 4 * n);
            size_t off; int ld, oc, act;
            if (pn < 10) { off = OFF_FZ; ld = 512; oc = (pn - 8) * 256; act = 1; }
            else if (pn < 12) { off = OFF_Q; ld = 512; oc = (pn - 10) * 256; act = 3; }
            else if (pn < 14) { off = OFF_K; ld = 512; oc = (pn - 12) * 256; act = 0; }
            else if (pn < 16) { off = OFF_CZ; ld = 512; oc = (pn - 14) * 256; act = 1; }
            else { off = OFF_G; ld = 3072; oc = (pn - 16) * 256; act = 2; }
            h16* dst = (h16*)(ws + off) + (size_t)(pm * 256 + rl0) * ld + oc + cw;
#pragma unroll
            for (int ai = 0; ai < 2; ++ai)
#pragma unroll
                for (int m = 0; m < 4; ++m)
#pragma unroll
                    for (int bj = 0; bj < 2; ++bj) {
                        h8 o;
#pragma unroll
                        for (int n = 0; n < 2; ++n)
#pragma unroll
                            for (int j = 0; j < 4; ++j) {
                                float v = acc[ai][bj][m][n][j] + b[bj][n][j];
                                if (act == 1) v = silu_f(v); else if (act == 2) v = sigm_f(v); else if (act == 3) v *= 0.125f;
                                o[4 * n + j] = (h16)v;
                            }
                        *(h8*)(dst + (size_t)(128 * ai + 16 * m) * ld + 128 * bj) = o;
                    }
        } else {
            const bool lat = pm < TL / 256;
            const int bb = lat ? (pm >> 4) : (pm - TL / 256), pos0 = lat ? (pm & 15) * 256 : 0;
            h16* dst; int ld;
            if (pn < 30) {
                const int c0 = (pn - 28) * 256;
                if (lat) { dst = (h16*)(ws + OFF_VVL) + ((size_t)(bb * 512 + c0)) * 4096 + pos0; ld = 4096; }
                else { dst = (h16*)(ws + OFF_VVC) + ((size_t)(bb * 512 + c0)) * 256; ld = 256; }
            } else {
                const int part = (pn - 30) >> 1, c0 = ((pn - 30) & 1) * 256;
                if (lat) { dst = (h16*)(ws + OFF_VTL) + ((size_t)(bb * 512 + c0)) * 8192 + part * 4096 + pos0; ld = 8192; }
                else { dst = (h16*)(ws + OFF_VTC) + ((size_t)(bb * 512 + c0)) * 512 + part * 256; ld = 512; }
            }
#pragma unroll
            for (int ai = 0; ai < 2; ++ai)
#pragma unroll
                for (int m = 0; m < 4; ++m) {
                    const int rt = 128 * ai + 16 * m + rl0;
                    const float bv = bias[rt];
#pragma unroll
                    for (int bj = 0; bj < 2; ++bj) {
                        h8 o;
#pragma unroll
                        for (int n = 0; n < 2; ++n)
#pragma unroll
                            for (int j = 0; j < 4; ++j) o[4 * n + j] = (h16)(acc[ai][bj][m][n][j] + bv);
                        *(h8*)(dst + (size_t)rt * ld + 128 * bj + cw) = o;
                    }
                }
        }
    } else if (kind == K_DFT || kind == K_CDFT) {
        const int row0 = (kind == K_DFT) ? (u.aux * 4096 + pm * 256) : (TL + u.aux * 256);
        const float sc = (kind == K_DFT) ? (1.f / 64.f) : (1.f / 16.f);
        h16* dst = (h16*)(ws + OFF_FZ) + (size_t)(row0 + rl0) * 512 + pn * 256 + cw;
#pragma unroll
        for (int ai = 0; ai < 2; ++ai)
#pragma unroll
            for (int m = 0; m < 4; ++m)
#pragma unroll
                for (int bj = 0; bj < 2; ++bj) {
                    h16* q = dst + (size_t)(128 * ai + 16 * m) * 512 + 128 * bj;
                    const h8 fz = *(const h8*)q; h8 o;
#pragma unroll
                    for (int n = 0; n < 2; ++n)
#pragma unroll
                        for (int j = 0; j < 4; ++j) o[4 * n + j] = (h16)(acc[ai][bj][m][n][j] * sc * (float)fz[4 * n + j]);
                    *(h8*)q = o;
                    asm volatile("" ::: "memory");
                }
    } else if (kind == K_MERGE) {
        const int br = u.aux;
        const h16* gp = (const h16*)(ws + OFF_G) + (size_t)(pm * 256 + rl0) * 3072 + br * 1024 + pn * 256 + cw;
        h16* mp = (h16*)(ws + OFF_M) + (size_t)(pm * 256 + rl0) * 1024 + pn * 256 + cw;
#pragma unroll
        for (int ai = 0; ai < 2; ++ai)
#pragma unroll
            for (int m = 0; m < 4; ++m)
#pragma unroll
                for (int bj = 0; bj < 2; ++bj) {
                    const size_t ro = (size_t)(128 * ai + 16 * m);
                    const h8 g = *(const h8*)(gp + ro * 3072 + 128 * bj);
                    h16* q = mp + ro * 1024 + 128 * bj;
                    h8 o;
                    if (br == 0) {
#pragma unroll
                        for (int n = 0; n < 2; ++n)
#pragma unroll
                            for (int j = 0; j < 4; ++j) o[4 * n + j] = (h16)(acc[ai][bj][m][n][j] * (float)g[4 * n + j]);
                    } else {
                        const h8 pv = *(const h8*)q;
#pragma unroll
                        for (int n = 0; n < 2; ++n)
#pragma unroll
                            for (int j = 0; j < 4; ++j) o[4 * n + j] = (h16)((float)pv[4 * n + j] + acc[ai][bj][m][n][j] * (float)g[4 * n + j]);
                    }
                    *(h8*)q = o;
                    asm volatile("" ::: "memory");
                }
    } else {
        const bool lat = pm < TL / 256;
        const float* res; float* dst; const float* gt;
        const float* MOD = (const float*)(ws + OFF_MOD) + (size_t)l * 17 * 3072 + 2048;
        if (lat) {
            const size_t t0 = ((size_t)ch * TL + pm * 256) * 1024;
            res = ((l == 0) ? p.x : p.out) + t0; dst = p.out + t0; gt = MOD + (size_t)(ch * BC + (pm >> 4)) * 3072;
        } else {
            const size_t t0 = ((size_t)ch * TX + (pm - TL / 256) * 256) * 1024;
            res = ((l == 0) ? p.ctx : (const float*)(ws + OFF_CTXR)) + t0; dst = (float*)(ws + OFF_CTXR) + t0; gt = MOD + (size_t)16 * 3072;
        }
        const int c0 = pn * 256 + cw;
        f32x4 gv[2][2];
#pragma unroll
        for (int bj = 0; bj < 2; ++bj)
#pragma unroll
            for (int n = 0; n < 2; ++n) gv[bj][n] = *(const f32x4*)(gt + c0 + 128 * bj + 4 * n);
#pragma unroll
        for (int ai = 0; ai < 2; ++ai)
#pragma unroll
            for (int m = 0; m < 4; ++m) {
                const size_t ro = (size_t)(128 * ai + 16 * m + rl0) * 1024 + c0;
#pragma unroll
                for (int bj = 0; bj < 2; ++bj)
#pragma unroll
                    for (int n = 0; n < 2; ++n) {
                        const f32x4 r = *(const f32x4*)(res + ro + 128 * bj + 4 * n);
                        *(f32x4*)(dst + ro + 128 * bj + 4 * n) = r + gv[bj][n] * acc[ai][bj][m][n];
                    }
                asm volatile("" ::: "memory");
            }
    }
}

__device__ __forceinline__ void gemm_phase(const Params& p, LAS unsigned char* lds, const int kind, const int l, const int ch, const int K, const int tid, const int bid) {
    const int wid = __builtin_amdgcn_readfirstlane(tid >> 6), lane = tid & 63, wr = wid >> 2, wc = wid & 3, fr = lane & 15, fq = lane >> 4;
    const int nt = K / BK;
    unsigned voffA[2], voffB[2];
#pragma unroll
    for (int i = 0; i < 2; ++i) { int R, C; stage_rc(tid * 16 + i * 8192, R, C); const int Rb = (R & ~31) + perm32(R & 31);
        voffA[i] = (unsigned)(R * K + C) * 2u; voffB[i] = (unsigned)(Rb * K + C) * 2u; }
    const size_t kstep = (size_t)(BK * 2);
    const size_t hstep = (size_t)HALF * K * 2;
    const unsigned ldsw = (unsigned)wid * 1024u;
    const int aoff = lds_byte(wr * 64 + fr, fq * 8), boff = lds_byte(wc * 32 + fr, fq * 8);
#define PG8_SA(b, h) (((b) * 2 + (h)) * HTB)
#define PG8_SB(b, h) ((4 + (b) * 2 + (h)) * HTB)
#define PG8_STAGE(bufoff, gbase, voff) do { _Pragma("unroll") for (int _i = 0; _i < 2; ++_i) \
        __builtin_amdgcn_global_load_lds((const unsigned*)((const char*)(gbase) + (voff)[_i]), (LAS unsigned*)(lds + (bufoff) + ldsw + _i * 8192), 16, 0, 0); } while (0)
#define PG8_LDA(dst, b, h) do { _Pragma("unroll") for (int m = 0; m < 4; ++m) _Pragma("unroll") for (int k = 0; k < 2; ++k) dst[m][k] = *(const LAS h8*)(lds + PG8_SA(b, h) + aoff + m * 2048 + k * 1024); } while (0)
#define PG8_LDB(dst, b, h) do { _Pragma("unroll") for (int n = 0; n < 2; ++n) _Pragma("unroll") for (int k = 0; k < 2; ++k) dst[n][k] = *(const LAS h8*)(lds + PG8_SB(b, h) + boff + n * 2048 + k * 1024); } while (0)
#define PG8_MMA(ai, bj, At, Bt) do { __builtin_amdgcn_s_setprio(1); _Pragma("unroll") for (int m = 0; m < 4; ++m) _Pragma("unroll") for (int n = 0; n < 2; ++n) _Pragma("unroll") for (int k = 0; k < 2; ++k) \
        acc[ai][bj][m][n] = __builtin_amdgcn_mfma_f32_16x16x32_f16(Bt[n][k], At[m][k], acc[ai][bj][m][n], 0, 0, 0); __builtin_amdgcn_s_setprio(0); } while (0)
#define PG8_WAIT_V(n) asm volatile("s_waitcnt vmcnt(" #n ")" ::: "memory")
#define PG8_WAIT_L(n) asm volatile("s_waitcnt lgkmcnt(" #n ")" ::: "memory")
#define PG8_BAR __builtin_amdgcn_s_barrier()
#define PG8_SCHED __builtin_amdgcn_sched_barrier(0)
    Unit cur, nxt; int ui = 0;
    if (!sched_next(p, kind, l, 0, cur, bid)) return;
    f32x4 acc[2][2][4][2];
#pragma unroll
    for (int a = 0; a < 2; ++a)
#pragma unroll
        for (int b = 0; b < 2; ++b)
#pragma unroll
            for (int m = 0; m < 4; ++m)
#pragma unroll
                for (int n = 0; n < 2; ++n) acc[a][b][m][n] = (f32x4){0.f, 0.f, 0.f, 0.f};
    h8 At[4][2], B0[2][2], B1[2][2];
    const char* cA = cur.A; const char* cB = cur.B;
    PG8_STAGE(PG8_SB(0, 0), cB, voffB); PG8_STAGE(PG8_SA(0, 0), cA, voffA); PG8_STAGE(PG8_SB(0, 1), cB + hstep, voffB); PG8_STAGE(PG8_SA(0, 1), cA + hstep, voffA);
    if (wr == 1) PG8_BAR;
    PG8_WAIT_V(4); PG8_BAR;
    PG8_STAGE(PG8_SB(1, 0), cB + kstep, voffB); PG8_STAGE(PG8_SA(1, 0), cA + kstep, voffA); PG8_STAGE(PG8_SB(1, 1), cB + hstep + kstep, voffB);
    PG8_WAIT_V(6); PG8_BAR;
    for (;;) {
        const bool has_next = sched_next(p, kind, l, ui + 1, nxt, bid);
        const char* nA = has_next ? nxt.A : cA; const char* nB = has_next ? nxt.B : cB;
        for (int t = 0; t < nt; t += 2) {
            const bool last = (t == nt - 2);
            const char* a1 = cA + (size_t)(t + 1) * kstep;
            const char* a2 = last ? nA : cA + (size_t)(t + 2) * kstep; const char* b2 = last ? nB : cB + (size_t)(t + 2) * kstep;
            const char* a3 = a2 + kstep; const char* b3 = b2 + kstep;
            PG8_LDB(B0, 0, 0); PG8_SCHED; PG8_LDA(At, 0, 0); PG8_STAGE(PG8_SA(1, 1), a1 + hstep, voffA);
            PG8_WAIT_L(8); PG8_BAR; PG8_WAIT_L(0); PG8_MMA(0, 0, At, B0); PG8_BAR; PG8_SCHED;
            PG8_LDB(B1, 0, 1); PG8_STAGE(PG8_SB(0, 0), b2, voffB);
            PG8_BAR; PG8_WAIT_L(0); PG8_MMA(0, 1, At, B1); PG8_BAR;
            PG8_LDA(At, 0, 1); PG8_STAGE(PG8_SA(0, 0), a2, voffA);
            PG8_BAR; PG8_WAIT_L(0); PG8_MMA(1, 0, At, B0); PG8_BAR; PG8_SCHED;
            PG8_STAGE(PG8_SB(0, 1), b2 + hstep, voffB);
            PG8_WAIT_V(6); PG8_BAR; PG8_MMA(1, 1, At, B1); PG8_BAR;
            PG8_LDB(B0, 1, 0); PG8_SCHED; PG8_LDA(At, 1, 0); PG8_STAGE(PG8_SA(0, 1), a2 + hstep, voffA);
            PG8_WAIT_L(8); PG8_BAR; PG8_WAIT_L(0); PG8_MMA(0, 0, At, B0); PG8_BAR; PG8_SCHED;
            PG8_LDB(B1, 1, 1); PG8_STAGE(PG8_SB(1, 0), b3, voffB);
            PG8_BAR; PG8_WAIT_L(0); PG8_MMA(0, 1, At, B1); PG8_BAR;
            PG8_LDA(At, 1, 1); PG8_STAGE(PG8_SA(1, 0), a3, voffA);
            PG8_BAR; PG8_WAIT_L(0); PG8_MMA(1, 0, At, B0); PG8_BAR; PG8_SCHED;
            PG8_STAGE(PG8_SB(1, 1), b3 + hstep, voffB);
            PG8_WAIT_V(6); PG8_BAR; PG8_MMA(1, 1, At, B1); PG8_BAR;
        }
        epilogue(p, kind, l, ch, cur, acc, wr, wc, fr, fq);
        if (!has_next) break;
#pragma unroll
        for (int a = 0; a < 2; ++a)
#pragma unroll
            for (int b = 0; b < 2; ++b)
#pragma unroll
                for (int m = 0; m < 4; ++m)
#pragma unroll
                    for (int n = 0; n < 2; ++n) acc[a][b][m][n] = (f32x4){0.f, 0.f, 0.f, 0.f};
        cur = nxt; cA = nA; cB = nB; ++ui;
    }
    PG8_WAIT_V(0);
    if (wr == 0) PG8_BAR;
    PG8_BAR;
#undef PG8_SA
#undef PG8_SB
#undef PG8_STAGE
#undef PG8_LDA
#undef PG8_LDB
#undef PG8_MMA
#undef PG8_WAIT_V
#undef PG8_WAIT_L
#undef PG8_BAR
#undef PG8_SCHED
}

constexpr int N_PHASES = 1 + DEPTH * NCH * 5 + 1;

__global__ void __launch_bounds__(NTHREADS, 2) fwd_megakernel(Params p) {
    extern __shared__ __attribute__((aligned(16))) unsigned char lds_raw[];
    LAS unsigned char* lds = (LAS unsigned char*)lds_raw;
    cg::grid_group grid = cg::this_grid();
    for (int ph = p.ph_lo; ph < p.ph_hi; ++ph) {
        int tid = threadIdx.x, bid = blockIdx.x;
        asm volatile("" : "+v"(tid)); asm volatile("" : "+s"(bid));
        if (ph == 0) {
            p0_prologue(p, lds, tid, bid);
        } else if (ph == N_PHASES - 1) {
            pf_final(p, tid, bid);
        } else {
            const int q = ph - 1, s = q % 5, lc = q / 5, ch = lc % NCH, l = lc / NCH;
            if (s == 0) p1_norm(p, l, ch, tid, bid);
            else if (s == 1) gemm_phase(p, lds, K_IN, l, ch, 1024, tid, bid);
            else if (s == 2) {
                gemm_phase(p, lds, K_DFT, l, ch, 8192, tid, bid);
                if (l < DEPTH - 1) gemm_phase(p, lds, K_CDFT, l, ch, 512, tid, bid);
                p3_conv(p, l, tid, bid);
                p3_attn(p, l, (LAS float*)(lds + LDS_STAGE), tid, bid);
            }
            else if (s == 3) gemm_phase(p, lds, K_MERGE, l, ch, 512, tid, bid);
            else gemm_phase(p, lds, K_OUT, l, ch, 1024, tid, bid);
        }
        if (ph + 1 < p.ph_hi) grid.sync();
    }
}

extern "C" void kernel_launch(void* const* d_in, const int* in_sizes, int n_in, void* d_out, int out_size, void* d_ws, size_t ws_size, hipStream_t stream) {
    static int grid_blocks = 0;
    if (!grid_blocks) {
        int dev = 0, cus = 0, per_cu = 0;
        hipGetDevice(&dev);
        hipDeviceGetAttribute(&cus, hipDeviceAttributeMultiprocessorCount, dev);
        if (hipFuncSetAttribute((const void*)fwd_megakernel, hipFuncAttributeMaxDynamicSharedMemorySize, LDS_BYTES) != hipSuccess) fprintf(stderr, "kernel_launch: hipFuncSetAttribute failed\n");
        hipOccupancyMaxActiveBlocksPerMultiprocessor(&per_cu, (const void*)fwd_megakernel, NTHREADS, LDS_BYTES);
        if (per_cu < 1) { fprintf(stderr, "kernel_launch: occupancy query says %d blocks/CU\n", per_cu); per_cu = 1; }
        (void)hipGetLastError();
        grid_blocks = cus * per_cu;
        if (ws_size < WS_END) fprintf(stderr, "kernel_launch: workspace too small: %zu < %zu\n", ws_size, (size_t)WS_END);
    }
    Params p{};
    const float** f = (const float**)&p;
    for (int i = 0; i < 17; ++i) f[i] = (const float*)d_in[i];
    p.out = (float*)d_out; p.ws = (unsigned char*)d_ws;
#if MULTI_LAUNCH
    for (int ph = 0; ph < N_PHASES; ++ph) {
        p.ph_lo = ph; p.ph_hi = ph + 1;
        hipLaunchKernelGGL(fwd_megakernel, dim3(grid_blocks), dim3(NTHREADS), LDS_BYTES, stream, p);
    }
#else
    p.ph_lo = 0; p.ph_hi = N_PHASES;
    void* args[] = {&p};
    hipError_t e = hipLaunchCooperativeKernel((const void*)fwd_megakernel, dim3(grid_blocks), dim3(NTHREADS), args, LDS_BYTES, stream);
    if (e != hipSuccess) fprintf(stderr, "cooperative launch failed: %s (grid %d)\n", hipGetErrorString(e), grid_blocks);
#endif
}
```

```cpp
#include <hip/hip_runtime.h>
#include <hip/hip_cooperative_groups.h>
#include <cstdio>
namespace cg = cooperative_groups;

#define LAS __attribute__((address_space(3)))
typedef _Float16 h16;
typedef _Float16 h8 __attribute__((ext_vector_type(8)));
typedef _Float16 h4 __attribute__((ext_vector_type(4)));
typedef float f32x4 __attribute__((ext_vector_type(4)));

#ifndef MULTI_LAUNCH
#define MULTI_LAUNCH 0
#endif
#define REP_P0 0
#define REP_P2 0
#define REP_DFT 0
#define REP_ATT 0
#define REP_P4 0

constexpr int DM = 1024, NBATCH = 16, SEQ = 4096, DEPTH = 4, CTXL = 256, DIN = 8192;
constexpr int BC = 8, NCH = 2;
constexpr int TL = BC * SEQ, TX = BC * CTXL, TC = TL + TX;
constexpr int NIN = 8704;
constexpr int NTHREADS = 512;
constexpr int LDS_STAGE = 131072, LDS_BYTES = LDS_STAGE + 16384;

constexpr size_t al256(size_t x) { return (x + 255) & ~(size_t)255; }
constexpr size_t OFF_WIN = 0;
constexpr size_t OFF_BIN = al256(OFF_WIN + (size_t)DEPTH * NIN * 1024 * 2);
constexpr size_t OFF_WBR = al256(OFF_BIN + (size_t)DEPTH * NIN * 4);
constexpr size_t OFF_WOUT = al256(OFF_WBR + (size_t)DEPTH * 3 * 1024 * 512 * 2);
constexpr size_t OFF_CS = al256(OFF_WOUT + (size_t)DEPTH * 1024 * 1024 * 2);
constexpr size_t OFF_CS2 = al256(OFF_CS + (size_t)4096 * 8192 * 2);
constexpr size_t OFF_MOD = al256(OFF_CS2 + (size_t)256 * 512 * 2);
constexpr size_t OFF_CTXR = al256(OFF_MOD + (size_t)DEPTH * 17 * 3072 * 4);
constexpr size_t OFF_H = al256(OFF_CTXR + (size_t)NBATCH * CTXL * 1024 * 4);
constexpr size_t OFF_M = al256(OFF_H + (size_t)TC * 1024 * 2);
constexpr size_t SZ512 = (size_t)TC * 512 * 2;
constexpr size_t OFF_CX = al256(OFF_M + (size_t)TC * 1024 * 2);
constexpr size_t OFF_BZ = al256(OFF_CX + SZ512);
constexpr size_t OFF_FZ = al256(OFF_BZ + SZ512);
constexpr size_t OFF_Q = al256(OFF_FZ + SZ512);
constexpr size_t OFF_K = al256(OFF_Q + SZ512);
constexpr size_t OFF_CZ = al256(OFF_K + SZ512);
constexpr size_t OFF_AACT = al256(OFF_CZ + SZ512);
constexpr size_t OFF_G = al256(OFF_AACT + SZ512);
constexpr size_t OFF_VTL = al256(OFF_G + (size_t)TC * 3072 * 2);
constexpr size_t OFF_VTC = al256(OFF_VTL + (size_t)BC * 512 * 8192 * 2);
constexpr size_t OFF_VVL = al256(OFF_VTC + (size_t)BC * 512 * 512 * 2);
constexpr size_t OFF_VVC = al256(OFF_VVL + (size_t)BC * 512 * 4096 * 2);
constexpr size_t WS_END = al256(OFF_VVC + (size_t)BC * 512 * 256 * 2);

struct Params {
    const float *x, *c, *ctx, *c_ctx, *norm_g, *w_ada, *b_ada, *w_in, *b_in, *w_conv, *b_conv, *rpb, *w_br_a, *w_br_f, *w_br_c, *w_out, *final_g;
    float* out; unsigned char* ws; int ph_lo, ph_hi;
};

__device__ __forceinline__ float silu_f(float v) { return v * __builtin_amdgcn_rcpf(1.f + __expf(-v)); }
__device__ __forceinline__ float sigm_f(float v) { return __builtin_amdgcn_rcpf(1.f + __expf(-v)); }

__device__ __forceinline__ int in_col(int n) {
    const int j = n >> 8, w = n & 255;
    if (j < 4) return (w < 128) ? (128 * j + w) : (1024 + 128 * j + (w - 128));
    if (j < 8) return (w < 128) ? (512 + 128 * (j - 4) + w) : (1536 + 128 * (j - 4) + (w - 128));
    if (j < 10) return 2560 + (j - 8) * 256 + w;
    if (j < 12) return 3072 + (j - 10) * 256 + w;
    if (j < 14) return 3584 + (j - 12) * 256 + w;
    if (j < 16) return 4608 + (j - 14) * 256 + w;
    if (j < 28) return 5120 + (j - 16) * 256 + w;
    return 4096 + (n - 7168);
}

template <bool PERMCOL>
__device__ __forceinline__ void transpose_tile(const int tid, const float* __restrict__ src, int lds_, h16* __restrict__ dst, int ldd, int k0, int n0, LAS float* t) {
    const int a = tid & 63, b = tid >> 6;
    const int col = PERMCOL ? in_col(n0 + a) : (n0 + a);
#pragma unroll
    for (int it = 0; it < 8; ++it) { const int k = b + it * 8; t[k * 65 + a] = src[(size_t)(k0 + k) * lds_ + col]; }
    __syncthreads();
#pragma unroll
    for (int it = 0; it < 8; ++it) { const int n = b + it * 8; dst[(size_t)(n0 + n) * ldd + k0 + a] = (h16)t[a * 65 + n]; }
    __syncthreads();
}

__device__ __forceinline__ void p0_prologue(const Params& p, LAS unsigned char* lds, const int tid, const int bid) {
    const int G = gridDim.x;
    unsigned char* ws = p.ws;
    LAS float* lf = (LAS float*)lds;
    constexpr int N_MOD = DEPTH * 24;
    constexpr int N_TIN = DEPTH * 120 * 16;
    constexpr int N_FOU = DEPTH * 1024;
    constexpr int N_BIAS = DEPTH;
    constexpr int N_TBR = DEPTH * 3 * 16 * 8;
    constexpr int N_TOUT = DEPTH * 16 * 16;
    constexpr int N_CS = 8192;
    constexpr int N_CS2 = 32;
    constexpr int E0 = N_MOD, E1 = E0 + N_TIN, E2 = E1 + N_FOU, E3 = E2 + N_BIAS, E4 = E3 + N_TBR, E5 = E4 + N_TOUT, E6 = E5 + N_CS, E7 = E6 + N_CS2;
    for (int it = bid; it < E7; it += G) {
        if (it < E0) {
            const int l = it / 24, cb = it % 24;
            for (int i = tid; i < 17 * 1024; i += NTHREADS) { const float v = (i < 16 * 1024) ? p.c[i] : p.c_ctx[i - 16 * 1024]; lf[i] = silu_f(v); }
            __syncthreads();
            const int col = cb * 128 + (tid & 127), kq = tid >> 7;
            float acc[17];
#pragma unroll
            for (int j = 0; j < 17; ++j) acc[j] = 0.f;
            const float* wp = p.w_ada + (size_t)l * 1024 * 3072 + col;
            for (int k = kq * 256; k < kq * 256 + 256; ++k) {
                const float w = wp[(size_t)k * 3072];
#pragma unroll
                for (int j = 0; j < 17; ++j) acc[j] += lf[j * 1024 + k] * w;
            }
            LAS float* red = lf + 17 * 1024;
#pragma unroll
            for (int j = 0; j < 17; ++j) red[(kq * 17 + j) * 128 + (tid & 127)] = acc[j];
            __syncthreads();
            float* MOD = (float*)(ws + OFF_MOD);
            for (int i = tid; i < 17 * 128; i += NTHREADS) {
                const int j = i >> 7, cc = i & 127;
                const float s = red[(0 * 17 + j) * 128 + cc] + red[(1 * 17 + j) * 128 + cc] + red[(2 * 17 + j) * 128 + cc] + red[(3 * 17 + j) * 128 + cc];
                MOD[((size_t)l * 17 + j) * 3072 + cb * 128 + cc] = s + p.b_ada[l * 3072 + cb * 128 + cc];
            }
            __syncthreads();
        } else if (it < E1) {
            const int t = it - E0, l = t / (120 * 16), r = t % (120 * 16), nt = r / 16, kt = r % 16;
            transpose_tile<true>(tid, p.w_in + (size_t)l * 1024 * DIN, DIN, (h16*)(ws + OFF_WIN) + (size_t)l * NIN * 1024, 1024, kt * 64, nt * 64, lf);
        } else if (it < E2) {
            const int t = it - E1, l = t >> 10, k = t & 1023;
            lf[tid] = p.w_in[((size_t)l * 1024 + k) * DIN + 2048 + tid];
            if (tid < 128) { lf[512 + tid] = cospif((float)tid * (1.f / 64.f)); lf[640 + tid] = sinpif((float)tid * (1.f / 64.f)); }
            __syncthreads();
            const int g = tid >> 7, kk = tid & 127;
            float re = 0.f, im = 0.f;
            for (int n2 = 0; n2 < 128; ++n2) { const float w = lf[g * 128 + n2]; const int ix = (n2 * kk) & 127; re += w * lf[512 + ix]; im -= w * lf[640 + ix]; }
            h16* W = (h16*)(ws + OFF_WIN) + (size_t)l * NIN * 1024;
            W[(size_t)(7680 + tid) * 1024 + k] = (h16)(re * 0.08838834764831845f);
            W[(size_t)(7680 + 512 + tid) * 1024 + k] = (h16)(im * 0.08838834764831845f);
            __syncthreads();
        } else if (it < E3) {
            const int l = it - E2;
            float* B = (float*)(ws + OFF_BIN) + (size_t)l * NIN;
            const float* bi = p.b_in + (size_t)l * DIN;
            for (int n = tid; n < 7680; n += NTHREADS) B[n] = bi[in_col(n)];
            const int g = tid >> 7, kk = tid & 127;
            float re = 0.f, im = 0.f;
            for (int n2 = 0; n2 < 128; ++n2) { const float w = bi[2048 + g * 128 + n2]; const float ang = (float)((n2 * kk) & 127) * (1.f / 64.f); re += w * cospif(ang); im -= w * sinpif(ang); }
            B[7680 + tid] = re * 0.08838834764831845f; B[7680 + 512 + tid] = im * 0.08838834764831845f;
        } else if (it < E4) {
            const int t = it - E3, lb = t / 128, r = t % 128, nt = r / 8, kt = r % 8, l = lb / 3, br = lb % 3;
            const float* src = (br == 0 ? p.w_br_a : (br == 1 ? p.w_br_f : p.w_br_c)) + (size_t)l * 512 * 1024;
            transpose_tile<false>(tid, src, 1024, (h16*)(ws + OFF_WBR) + (size_t)lb * 1024 * 512, 512, kt * 64, nt * 64, lf);
        } else if (it < E5) {
            const int t = it - E4, l = t / 256, r = t % 256, nt = r / 16, kt = r % 16;
            transpose_tile<false>(tid, p.w_out + (size_t)l * 1024 * 1024, 1024, (h16*)(ws + OFF_WOUT) + (size_t)l * 1024 * 1024, 1024, kt * 64, nt * 64, lf);
        } else if (it < E6) {
            const size_t e0 = ((size_t)(it - E5) * NTHREADS + tid) * 8;
            const int k1 = (int)(e0 >> 13), j0 = (int)(e0 & 8191);
            h8 o;
#pragma unroll
            for (int j = 0; j < 8; ++j) { const int jj = j0 + j, pos = jj & 4095; const float ang = (float)((k1 * pos) & 4095) * (1.f / 2048.f); o[j] = (h16)((jj < 4096) ? cospif(ang) : sinpif(ang)); }
            *(h8*)((h16*)(ws + OFF_CS) + e0) = o;
        } else {
            const size_t e0 = ((size_t)(it - E6) * NTHREADS + tid) * 8;
            const int k1 = (int)(e0 >> 9), j0 = (int)(e0 & 511);
            h8 o;
#pragma unroll
            for (int j = 0; j < 8; ++j) { const int jj = j0 + j, pos = jj & 255; const float ang = (float)((k1 * pos) & 255) * (1.f / 128.f); o[j] = (h16)((jj < 256) ? cospif(ang) : sinpif(ang)); }
            *(h8*)((h16*)(ws + OFF_CS2) + e0) = o;
        }
    }
}

__device__ __forceinline__ void p1_norm(const Params& p, int l, int ch, const int tid, const int bid) {
    const int lane = tid & 63, wid = tid >> 6;
    unsigned char* ws = p.ws;
    const float* xsrc = (l == 0) ? p.x : p.out;
    const float* csrc = (l == 0) ? p.ctx : (const float*)(ws + OFF_CTXR);
    const float* MOD = (const float*)(ws + OFF_MOD) + (size_t)l * 17 * 3072;
    const float* ng = p.norm_g + l * 1024;
    h16* H = (h16*)(ws + OFF_H);
    for (int row = bid * 8 + wid; row < TC; row += gridDim.x * 8) {
        const float* src = (row < TL) ? xsrc + ((size_t)ch * TL + row) * 1024 : csrc + ((size_t)ch * TX + (row - TL)) * 1024;
        const float* mod = MOD + (size_t)((row < TL) ? (ch * BC + (row >> 12)) : 16) * 3072;
        f32x4 v[4]; float ss = 0.f;
#pragma unroll
        for (int it = 0; it < 4; ++it) { v[it] = *(const f32x4*)(src + it * 256 + lane * 4); ss += v[it][0] * v[it][0] + v[it][1] * v[it][1] + v[it][2] * v[it][2] + v[it][3] * v[it][3]; }
#pragma unroll
        for (int o = 32; o >= 1; o >>= 1) ss += __shfl_xor(ss, o);
        const float inv = rsqrtf(ss * (1.f / 1024.f) + 1e-6f);
#pragma unroll
        for (int it = 0; it < 4; ++it) {
            const int c = it * 256 + lane * 4;
            const f32x4 g = *(const f32x4*)(ng + c), sh = *(const f32x4*)(mod + c), sc = *(const f32x4*)(mod + 1024 + c);
            h4 o;
#pragma unroll
            for (int j = 0; j < 4; ++j) o[j] = (h16)(v[it][j] * inv * g[j] * (1.f + sc[j]) + sh[j]);
            *(h4*)(H + (size_t)row * 1024 + c) = o;
        }
    }
}

__device__ __forceinline__ void pf_final(const Params& p, const int tid, const int bid) {
    const int lane = tid & 63, wid = tid >> 6;
    for (int row = bid * 8 + wid; row < NBATCH * SEQ; row += gridDim.x * 8) {
        float* src = p.out + (size_t)row * 1024;
        f32x4 v[4]; float ss = 0.f;
#pragma unroll
        for (int it = 0; it < 4; ++it) { v[it] = *(const f32x4*)(src + it * 256 + lane * 4); ss += v[it][0] * v[it][0] + v[it][1] * v[it][1] + v[it][2] * v[it][2] + v[it][3] * v[it][3]; }
#pragma unroll
        for (int o = 32; o >= 1; o >>= 1) ss += __shfl_xor(ss, o);
        const float inv = rsqrtf(ss * (1.f / 1024.f) + 1e-6f);
#pragma unroll
        for (int it = 0; it < 4; ++it) { const int c = it * 256 + lane * 4; const f32x4 g = *(const f32x4*)(p.final_g + c); *(f32x4*)(src + c) = v[it] * inv * g; }
    }
}

__device__ __forceinline__ void p3_conv(const Params& p, int l, const int tid, const int bid) {
    unsigned char* ws = p.ws;
    const h16* CX = (const h16*)(ws + OFF_CX); const h16* BZ = (const h16*)(ws + OFF_BZ); h16* AA = (h16*)(ws + OFF_AACT);
    const float* wc = p.w_conv + (size_t)l * 3 * 512; const float* bc = p.b_conv + (size_t)l * 512;
    const int nrows = (l == DEPTH - 1) ? TL : TC;
    for (int idx = bid * NTHREADS + tid; idx < nrows * 64; idx += gridDim.x * NTHREADS) {
        const int row = idx >> 6, c8 = (idx & 63) * 8;
        const int pos = (row < TL) ? (row & 4095) : ((row - TL) & 255), L = (row < TL) ? 4096 : 256;
        const h8 z = {0, 0, 0, 0, 0, 0, 0, 0};
        const h8 cur = *(const h8*)(CX + (size_t)row * 512 + c8);
        const h8 prv = (pos > 0) ? *(const h8*)(CX + (size_t)(row - 1) * 512 + c8) : z;
        const h8 nxt = (pos < L - 1) ? *(const h8*)(CX + (size_t)(row + 1) * 512 + c8) : z;
        const h8 bz = *(const h8*)(BZ + (size_t)row * 512 + c8);
        h8 o;
#pragma unroll
        for (int j = 0; j < 8; ++j) {
            const float cv = wc[c8 + j] * (float)prv[j] + wc[512 + c8 + j] * (float)cur[j] + wc[1024 + c8 + j] * (float)nxt[j] + bc[c8 + j];
            o[j] = (h16)((float)bz[j] * cv);
        }
        *(h8*)(AA + (size_t)row * 512 + c8) = o;
    }
}

__device__ __forceinline__ void p3_attn(const Params& p, int l, LAS float* rpbL, const int tid, const int bid, const bool dummy) {
    const int lane = tid & 63, wid = tid >> 6, fr = lane & 15, fq = lane >> 4;
    unsigned char* ws = p.ws;
    const h16* Qb = (const h16*)(ws + OFF_Q); const h16* Kb = (const h16*)(ws + OFF_K);
    const h16* VVL = (const h16*)(ws + OFF_VVL); const h16* VVC = (const h16*)(ws + OFF_VVC);
    h16* CZ = (h16*)(ws + OFF_CZ);
    for (int i = tid; i < 8 * 15 * 31; i += NTHREADS) rpbL[i] = p.rpb[(size_t)l * 8 * 15 * 31 + i];
    __syncthreads();
    const f32x4 zero4 = {0.f, 0.f, 0.f, 0.f};
    for (int u = bid * 8 + wid; u < BC * 8 * 64 * 4; u += gridDim.x * 8) {
        const int n = u & 3, r = (u >> 2) & 63, h = (u >> 8) & 7, bb = u >> 11;
        const int tokQ = bb * 4096 + r * 64 + n * 16 + fr;
        const h16* qp = Qb + (size_t)tokQ * 512 + h * 64 + fq * 8;
        const h8 q0 = *(const h8*)qp, q1 = *(const h8*)(qp + 32);
        int kcs = n * 16 - 8; kcs = kcs < 0 ? 0 : (kcs > 32 ? 32 : kcs);
        int rs = r - 4; rs = rs < 0 ? 0 : (rs > 56 ? 56 : rs);
        const int qcol = n * 16 + fr; int cs = qcol - 8; cs = cs < 0 ? 0 : (cs > 48 ? 48 : cs);
        f32x4 s[32];
#pragma unroll
        for (int t = 0; t < 16; ++t) {
            const int i = t >> 1, par = t & 1;
            const int keytok = bb * 4096 + (rs + i) * 64 + kcs + 16 * par + fr;
            const h16* kp = Kb + (size_t)keytok * 512 + h * 64 + fq * 8;
            const h8 k0 = *(const h8*)kp, k1 = *(const h8*)(kp + 32);
            f32x4 a = zero4;
            a = __builtin_amdgcn_mfma_f32_16x16x32_f16(k0, q0, a, 0, 0, 0);
            a = __builtin_amdgcn_mfma_f32_16x16x32_f16(k1, q1, a, 0, 0, 0);
            const int kc0 = kcs + 16 * par + 4 * fq;
            const LAS float* bp = rpbL + (h * 15 + (rs + i - r + 7)) * 31;
#pragma unroll
            for (int j = 0; j < 4; ++j) {
                const int kcol = kc0 + j; const bool ok = (kcol >= cs) && (kcol < cs + 16);
                int dc = kcol - qcol + 15; dc = dc < 0 ? 0 : (dc > 30 ? 30 : dc);
                a[j] = ok ? a[j] + bp[dc] : -1e30f;
            }
            s[t] = a;
            if ((t & 3) == 3) asm volatile("" ::: "memory");
        }
#pragma unroll
        for (int t = 16; t < 32; ++t) {
            const int keytok = TL + bb * 256 + (t - 16) * 16 + fr;
            const h16* kp = Kb + (size_t)keytok * 512 + h * 64 + fq * 8;
            const h8 k0 = *(const h8*)kp, k1 = *(const h8*)(kp + 32);
            f32x4 a = zero4;
            a = __builtin_amdgcn_mfma_f32_16x16x32_f16(k0, q0, a, 0, 0, 0);
            a = __builtin_amdgcn_mfma_f32_16x16x32_f16(k1, q1, a, 0, 0, 0);
            s[t] = a;
            if ((t & 3) == 3) asm volatile("" ::: "memory");
        }
        float mx = -3e38f;
#pragma unroll
        for (int t = 0; t < 32; ++t) mx = fmaxf(mx, fmaxf(fmaxf(s[t][0], s[t][1]), fmaxf(s[t][2], s[t][3])));
        mx = fmaxf(mx, __shfl_xor(mx, 16)); mx = fmaxf(mx, __shfl_xor(mx, 32));
        float sum = 0.f;
#pragma unroll
        for (int t = 0; t < 32; ++t) {
#pragma unroll
            for (int j = 0; j < 4; ++j) { const float e = __expf(s[t][j] - mx); s[t][j] = e; sum += e; }
        }
        sum += __shfl_xor(sum, 16); sum += __shfl_xor(sum, 32);
        f32x4 o[4] = {zero4, zero4, zero4, zero4};
#pragma unroll
        for (int tp = 0; tp < 16; ++tp) {
            h8 pf;
#pragma unroll
            for (int j = 0; j < 4; ++j) { pf[j] = (h16)s[2 * tp][j]; pf[4 + j] = (h16)s[2 * tp + 1][j]; }
#pragma unroll
            for (int dt = 0; dt < 4; ++dt) {
                const h16* vp = (tp < 8) ? VVL + ((size_t)(bb * 512 + h * 64 + 16 * dt + fr)) * 4096 + (rs + tp) * 64 + kcs + 4 * fq
                                         : VVC + ((size_t)(bb * 512 + h * 64 + 16 * dt + fr)) * 256 + (2 * tp - 16) * 16 + 4 * fq;
                const h4 v0 = *(const h4*)vp, v1 = *(const h4*)(vp + 16);
                const h8 vf = {v0[0], v0[1], v0[2], v0[3], v1[0], v1[1], v1[2], v1[3]};
                o[dt] = __builtin_amdgcn_mfma_f32_16x16x32_f16(vf, pf, o[dt], 0, 0, 0);
            }
            if ((tp & 1) == 1) asm volatile("" ::: "memory");
        }
        const float inv = 1.f / sum;
#pragma unroll
        for (int dt = 0; dt < 4; ++dt) {
            h16* cp = CZ + (size_t)tokQ * 512 + h * 64 + 16 * dt + 4 * fq;
            const h4 cz = *(const h4*)cp; h4 ov;
#pragma unroll
            for (int j = 0; j < 4; ++j) ov[j] = (h16)(o[dt][j] * inv * (float)cz[j]);
            if (dummy) cp = (h16*)((char*)cp - (OFF_CZ - OFF_H));
            *(h4*)cp = ov;
        }
    }
    if (l < DEPTH - 1) {
        for (int u = bid * 8 + wid; u < BC * 8 * 16; u += gridDim.x * 8) {
            const int qg = u & 15, h = (u >> 4) & 7, bb = u >> 7;
            const int tokQ = TL + bb * 256 + qg * 16 + fr;
            const h16* qp = Qb + (size_t)tokQ * 512 + h * 64 + fq * 8;
            const h8 q0 = *(const h8*)qp, q1 = *(const h8*)(qp + 32);
            f32x4 s[16];
#pragma unroll
            for (int t = 0; t < 16; ++t) {
                const int keytok = TL + bb * 256 + t * 16 + fr;
                const h16* kp = Kb + (size_t)keytok * 512 + h * 64 + fq * 8;
                const h8 k0 = *(const h8*)kp, k1 = *(const h8*)(kp + 32);
                f32x4 a = zero4;
                a = __builtin_amdgcn_mfma_f32_16x16x32_f16(k0, q0, a, 0, 0, 0);
                a = __builtin_amdgcn_mfma_f32_16x16x32_f16(k1, q1, a, 0, 0, 0);
                s[t] = a;
            }
            float mx = -3e38f;
#pragma unroll
            for (int t = 0; t < 16; ++t) mx = fmaxf(mx, fmaxf(fmaxf(s[t][0], s[t][1]), fmaxf(s[t][2], s[t][3])));
            mx = fmaxf(mx, __shfl_xor(mx, 16)); mx = fmaxf(mx, __shfl_xor(mx, 32));
            float sum = 0.f;
#pragma unroll
            for (int t = 0; t < 16; ++t) {
#pragma unroll
                for (int j = 0; j < 4; ++j) { const float e = __expf(s[t][j] - mx); s[t][j] = e; sum += e; }
            }
            sum += __shfl_xor(sum, 16); sum += __shfl_xor(sum, 32);
            f32x4 o[4] = {zero4, zero4, zero4, zero4};
#pragma unroll
            for (int tp = 0; tp < 8; ++tp) {
                h8 pf;
#pragma unroll
                for (int j = 0; j < 4; ++j) { pf[j] = (h16)s[2 * tp][j]; pf[4 + j] = (h16)s[2 * tp + 1][j]; }
#pragma unroll
                for (int dt = 0; dt < 4; ++dt) {
                    const h16* vp = VVC + ((size_t)(bb * 512 + h * 64 + 16 * dt + fr)) * 256 + (2 * tp) * 16 + 4 * fq;
                    const h4 v0 = *(const h4*)vp, v1 = *(const h4*)(vp + 16);
                    const h8 vf = {v0[0], v0[1], v0[2], v0[3], v1[0], v1[1], v1[2], v1[3]};
                    o[dt] = __builtin_amdgcn_mfma_f32_16x16x32_f16(vf, pf, o[dt], 0, 0, 0);
                }
            }
            const float inv = 1.f / sum;
#pragma unroll
            for (int dt = 0; dt < 4; ++dt) {
                h16* cp = CZ + (size_t)tokQ * 512 + h * 64 + 16 * dt + 4 * fq;
                const h4 cz = *(const h4*)cp; h4 ov;
#pragma unroll
                for (int j = 0; j < 4; ++j) ov[j] = (h16)(o[dt][j] * inv * (float)cz[j]);
                if (dummy) cp = (h16*)((char*)cp - (OFF_CZ - OFF_H));
                *(h4*)cp = ov;
            }
        }
    }
}

constexpr int BM = 256, BK = 64, HALF = 128, HTB = HALF * BK * 2;
enum { K_IN = 0, K_DFT = 1, K_CDFT = 2, K_MERGE = 3, K_OUT = 4 };
struct Unit { const char* A; const char* B; int pm, pn, aux; };

__device__ __forceinline__ int lds_byte(int r, int c) { const int st = (r >> 4) * 2 + (c >> 5), rr = r & 15, cc = c & 31, ob = rr * 64 + cc * 2; return st * 1024 + (ob ^ (((ob >> 9) & 1) << 5)); }
__device__ __forceinline__ void stage_rc(int b, int& R, int& C) { const int st = b / 1024, sb = b % 1024, swz = sb ^ (((sb >> 9) & 1) << 5); R = (st >> 1) * 16 + swz / 64; C = (st & 1) * 32 + (swz % 64) / 2; }
__device__ __forceinline__ int perm32(int rho) { const int n = rho >> 4, i = rho & 15; return 8 * (i >> 2) + 4 * n + (i & 3); }

__device__ __forceinline__ bool sched_next(const Params& p, const int kind, const int l, const int i, Unit& u, const int bid) {
    const int G = gridDim.x, c = bid;
    const char* ws = (const char*)p.ws;
    if (kind == K_IN) {
        constexpr int nM = TC / 256, nN = NIN / 256, nwg = nM * nN;
        const long L = (long)i * G + c; if (L >= nwg) return false;
        int wgid = (int)L; { const int q = nwg / 8, r = nwg % 8, xcd = wgid % 8, off = wgid / 8; wgid = (xcd < r ? xcd * (q + 1) : r * (q + 1) + (xcd - r) * q) + off; }
        const int nig = 8 * nN, gid = wgid / nig, fm = gid * 8, gsz = (nM - fm) < 8 ? (nM - fm) : 8;
        const int pm = fm + ((wgid % nig) % gsz), pn = (wgid % nig) / gsz;
        const char* Hp = ws + OFF_H + (size_t)pm * 256 * 1024 * 2;
        const char* Wp = ws + OFF_WIN + ((size_t)l * NIN + pn * 256) * 1024 * 2;
        if (pn < 28) { u.A = Hp; u.B = Wp; } else { u.A = Wp; u.B = Hp; }
        u.pm = pm; u.pn = pn; u.aux = 0; return true;
    } else if (kind == K_DFT) {
        const int L = i * G + c; if (L >= BC * 32) return false;
        const int bb = L & 7, j = L >> 3, pm = j >> 1, pn = j & 1;
        u.A = ws + OFF_CS + (size_t)pm * 256 * 8192 * 2; u.B = ws + OFF_VTL + ((size_t)(bb * 512 + pn * 256)) * 8192 * 2;
        u.pm = pm; u.pn = pn; u.aux = bb; return true;
    } else if (kind == K_CDFT) {
        const int L = i * G + c; if (L >= BC * 2) return false;
        const int bb = L >> 1, pn = L & 1;
        u.A = ws + OFF_CS2; u.B = ws + OFF_VTC + ((size_t)(bb * 512 + pn * 256)) * 512 * 2;
        u.pm = 0; u.pn = pn; u.aux = bb; return true;
    } else if (kind == K_MERGE) {
        const int ntile = ((l == DEPTH - 1) ? TL / 256 : TC / 256) * 4;
        const int ti = (i / 3) * G + c, br = i % 3; if (ti >= ntile) return false;
        const int pm = ti >> 2, pn = ti & 3;
        const size_t aoff = (br == 0) ? OFF_AACT : (br == 1 ? OFF_FZ : OFF_CZ);
        u.A = ws + aoff + (size_t)pm * 256 * 512 * 2; u.B = ws + OFF_WBR + ((size_t)((l * 3 + br) * 1024 + pn * 256)) * 512 * 2;
        u.pm = pm; u.pn = pn; u.aux = br; return true;
    } else {
        const int ntile = ((l == DEPTH - 1) ? TL / 256 : TC / 256) * 4;
        const int ti = i * G + c; if (ti >= ntile) return false;
        const int pm = ti >> 2, pn = ti & 3;
        u.A = ws + OFF_M + (size_t)pm * 256 * 1024 * 2; u.B = ws + OFF_WOUT + ((size_t)(l * 1024 + pn * 256)) * 1024 * 2;
        u.pm = pm; u.pn = pn; u.aux = 0; return true;
    }
}

__device__ __forceinline__ void epilogue(const Params& p, const int kind, const int l, const int ch, const Unit& u, f32x4 (&acc)[2][2][4][2], int wr, int wc, int fr, int fq) {
    unsigned char* ws = p.ws;
    const int cw = wc * 32 + 8 * fq, rl0 = wr * 64 + fr;
    const int pm = u.pm, pn = u.pn;
    if (kind == K_IN) {
        const float* bias = (const float*)(ws + OFF_BIN) + (size_t)l * NIN + pn * 256;
        if (pn < 8) {
            f32x4 b[2][2];
#pragma unroll
            for (int bj = 0; bj < 2; ++bj)
#pragma unroll
                for (int n = 0; n < 2; ++n) b[bj][n] = *(const f32x4*)(bias + 128 * bj + cw + 4 * n);
            h16* dst = (h16*)(ws + (pn < 4 ? OFF_CX : OFF_BZ)) + (size_t)(pm * 256 + rl0) * 512 + 128 * (pn & 3) + cw;
            const bool mul = pn < 4;
#pragma unroll
            for (int ai = 0; ai < 2; ++ai)
#pragma unroll
                for (int m = 0; m < 4; ++m) {
                    h8 o;
#pragma unroll
                    for (int n = 0; n < 2; ++n)
#pragma unroll
                        for (int j = 0; j < 4; ++j) {
                            const float v0 = acc[ai][0][m][n][j] + b[0][n][j], v1 = acc[ai][1][m][n][j] + b[1][n][j];
                            o[4 * n + j] = (h16)(mul ? v0 * v1 : v0 * silu_f(v1));
                        }
                    *(h8*)(dst + (size_t)(128 * ai + 16 * m) * 512) = o;
                }
        } else if (pn < 28) {
            f32x4 b[2][2];
#pragma unroll
            for (int bj = 0; bj < 2; ++bj)
#pragma unroll
                for (int n = 0; n < 2; ++n) b[bj][n] = *(const f32x4*)(bias + 128 * bj + cw + 4 * n);
            size_t off; int ld, oc, act;
            if (pn < 10) { off = OFF_FZ; ld = 512; oc = (pn - 8) * 256; act = 1; }
            else if (pn < 12) { off = OFF_Q; ld = 512; oc = (pn - 10) * 256; act = 3; }
            else if (pn < 14) { off = OFF_K; ld = 512; oc = (pn - 12) * 256; act = 0; }
            else if (pn < 16) { off = OFF_CZ; ld = 512; oc = (pn - 14) * 256; act = 1; }
            else { off = OFF_G; ld = 3072; oc = (pn - 16) * 256; act = 2; }
            h16* dst = (h16*)(ws + off) + (size_t)(pm * 256 + rl0) * ld + oc + cw;
#pragma unroll
            for (int ai = 0; ai < 2; ++ai)
#pragma unroll
                for (int m = 0; m < 4; ++m)
#pragma unroll
                    for (int bj = 0; bj < 2; ++bj) {
                        h8 o;
#pragma unroll
                        for (int n = 0; n < 2; ++n)
#pragma unroll
                            for (int j = 0; j < 4; ++j) {
                                float v = acc[ai][bj][m][n][j] + b[bj][n][j];
                                if (act == 1) v = silu_f(v); else if (act == 2) v = fmaxf(sigm_f(v), 6.2e-5f); else if (act == 3) v *= 0.125f;
                                o[4 * n + j] = (h16)v;
                            }
                        *(h8*)(dst + (size_t)(128 * ai + 16 * m) * ld + 128 * bj) = o;
                    }
        } else {
            const bool lat = pm < TL / 256;
            const int bb = lat ? (pm >> 4) : (pm - TL / 256), pos0 = lat ? (pm & 15) * 256 : 0;
            h16* dst; int ld;
            if (pn < 30) {
                const int c0 = (pn - 28) * 256;
                if (lat) { dst = (h16*)(ws + OFF_VVL) + ((size_t)(bb * 512 + c0)) * 4096 + pos0; ld = 4096; }
                else { dst = (h16*)(ws + OFF_VVC) + ((size_t)(bb * 512 + c0)) * 256; ld = 256; }
            } else {
                const int part = (pn - 30) >> 1, c0 = ((pn - 30) & 1) * 256;
                if (lat) { dst = (h16*)(ws + OFF_VTL) + ((size_t)(bb * 512 + c0)) * 8192 + part * 4096 + pos0; ld = 8192; }
                else { dst = (h16*)(ws + OFF_VTC) + ((size_t)(bb * 512 + c0)) * 512 + part * 256; ld = 512; }
            }
#pragma unroll
            for (int ai = 0; ai < 2; ++ai)
#pragma unroll
                for (int m = 0; m < 4; ++m) {
                    const int rt = 128 * ai + 16 * m + rl0;
                    const float bv = bias[rt];
#pragma unroll
                    for (int bj = 0; bj < 2; ++bj) {
                        h8 o;
#pragma unroll
                        for (int n = 0; n < 2; ++n)
#pragma unroll
                            for (int j = 0; j < 4; ++j) o[4 * n + j] = (h16)(acc[ai][bj][m][n][j] + bv);
                        *(h8*)(dst + (size_t)rt * ld + 128 * bj + cw) = o;
                    }
                }
        }
    } else if (kind == K_DFT || kind == K_CDFT) {
        const int row0 = (kind == K_DFT) ? (u.aux * 4096 + pm * 256) : (TL + u.aux * 256);
        const float sc = (kind == K_DFT) ? (1.f / 64.f) : (1.f / 16.f);
        h16* dst = (h16*)(ws + OFF_FZ) + (size_t)(row0 + rl0) * 512 + pn * 256 + cw;
#pragma unroll
        for (int ai = 0; ai < 2; ++ai) {
            h8 fz[4][2];
#pragma unroll
            for (int m = 0; m < 4; ++m)
#pragma unroll
                for (int bj = 0; bj < 2; ++bj) fz[m][bj] = *(const h8*)(dst + (size_t)(128 * ai + 16 * m) * 512 + 128 * bj);
#pragma unroll
            for (int m = 0; m < 4; ++m)
#pragma unroll
                for (int bj = 0; bj < 2; ++bj) {
                    h16* q = dst + (size_t)(128 * ai + 16 * m) * 512 + 128 * bj; h8 o;
                    if (ch & 0x100) q = (h16*)((char*)q - (OFF_FZ - OFF_H));
#pragma unroll
                    for (int n = 0; n < 2; ++n)
#pragma unroll
                        for (int j = 0; j < 4; ++j) o[4 * n + j] = (h16)(acc[ai][bj][m][n][j] * sc * (float)fz[m][bj][4 * n + j]);
                    *(h8*)q = o;
                }
            asm volatile("" ::: "memory");
        }
    } else if (kind == K_MERGE) {
        const int br = u.aux;
        const h16* gp = (const h16*)(ws + OFF_G) + (size_t)(pm * 256 + rl0) * 3072 + br * 1024 + pn * 256 + cw;
        h16* mp = (h16*)(ws + OFF_M) + (size_t)(pm * 256 + rl0) * 1024 + pn * 256 + cw;
#pragma unroll
        for (int ai = 0; ai < 2; ++ai) {
            h8 ga[4][2], gb[4][2];
#pragma unroll
            for (int m = 0; m < 4; ++m)
#pragma unroll
                for (int bj = 0; bj < 2; ++bj) {
                    const h16* q = gp + (size_t)(128 * ai + 16 * m) * 3072 + 128 * bj;
                    ga[m][bj] = *(const h8*)q;
                    if (br < 2) gb[m][bj] = *(const h8*)(q + 1024);
                }
#pragma unroll
            for (int m = 0; m < 4; ++m)
#pragma unroll
                for (int bj = 0; bj < 2; ++bj) {
                    if (br < 2) {
#pragma unroll
                        for (int n = 0; n < 2; ++n)
#pragma unroll
                            for (int j = 0; j < 4; ++j) acc[ai][bj][m][n][j] *= (float)ga[m][bj][4 * n + j] * __builtin_amdgcn_rcpf((float)gb[m][bj][4 * n + j]);
                    } else {
                        h8 o;
#pragma unroll
                        for (int n = 0; n < 2; ++n)
#pragma unroll
                            for (int j = 0; j < 4; ++j) o[4 * n + j] = (h16)(acc[ai][bj][m][n][j] * (float)ga[m][bj][4 * n + j]);
                        *(h8*)(mp + (size_t)(128 * ai + 16 * m) * 1024 + 128 * bj) = o;
                    }
                }
            asm volatile("" ::: "memory");
        }
    } else {
        const bool lat = pm < TL / 256;
        const float* res; float* dst; const float* gt;
        const float* MOD = (const float*)(ws + OFF_MOD) + (size_t)l * 17 * 3072 + 2048;
        if (lat) {
            const size_t t0 = ((size_t)ch * TL + pm * 256) * 1024;
            res = ((l == 0) ? p.x : p.out) + t0; dst = p.out + t0; gt = MOD + (size_t)(ch * BC + (pm >> 4)) * 3072;
        } else {
            const size_t t0 = ((size_t)ch * TX + (pm - TL / 256) * 256) * 1024;
            res = ((l == 0) ? p.ctx : (const float*)(ws + OFF_CTXR)) + t0; dst = (float*)(ws + OFF_CTXR) + t0; gt = MOD + (size_t)16 * 3072;
        }
        const int c0 = pn * 256 + cw;
        f32x4 gv[2][2];
#pragma unroll
        for (int bj = 0; bj < 2; ++bj)
#pragma unroll
            for (int n = 0; n < 2; ++n) gv[bj][n] = *(const f32x4*)(gt + c0 + 128 * bj + 4 * n);
#pragma unroll
        for (int ai = 0; ai < 2; ++ai) {
            f32x4 r[4][2][2];
#pragma unroll
            for (int m = 0; m < 4; ++m)
#pragma unroll
                for (int bj = 0; bj < 2; ++bj)
#pragma unroll
                    for (int n = 0; n < 2; ++n) r[m][bj][n] = *(const f32x4*)(res + (size_t)(128 * ai + 16 * m + rl0) * 1024 + c0 + 128 * bj + 4 * n);
#pragma unroll
            for (int m = 0; m < 4; ++m)
#pragma unroll
                for (int bj = 0; bj < 2; ++bj)
#pragma unroll
                    for (int n = 0; n < 2; ++n) *(f32x4*)(dst + (size_t)(128 * ai + 16 * m + rl0) * 1024 + c0 + 128 * bj + 4 * n) = r[m][bj][n] + gv[bj][n] * acc[ai][bj][m][n];
            asm volatile("" ::: "memory");
        }
    }
}

__device__ __forceinline__ void gemm_phase(const Params& p, LAS unsigned char* lds, const int kind, const int l, const int ch, const int K, const int tid, const int bid) {
    const int wid = __builtin_amdgcn_readfirstlane(tid >> 6), lane = tid & 63, wr = wid >> 2, wc = wid & 3, fr = lane & 15, fq = lane >> 4;
    const int nt = K / BK;
    unsigned voffA[2], voffB[2];
#pragma unroll
    for (int i = 0; i < 2; ++i) { int R, C; stage_rc(tid * 16 + i * 8192, R, C); const int Rb = (R & ~31) + perm32(R & 31);
        voffA[i] = (unsigned)(R * K + C) * 2u; voffB[i] = (unsigned)(Rb * K + C) * 2u; }
    const size_t kstep = (size_t)(BK * 2);
    const size_t hstep = (size_t)HALF * K * 2;
    const unsigned ldsw = (unsigned)wid * 1024u;
    const int aoff = lds_byte(wr * 64 + fr, fq * 8), boff = lds_byte(wc * 32 + fr, fq * 8);
#define PG8_SA(b, h) (((b) * 2 + (h)) * HTB)
#define PG8_SB(b, h) ((4 + (b) * 2 + (h)) * HTB)
#define PG8_STAGE(bufoff, gbase, voff) do { _Pragma("unroll") for (int _i = 0; _i < 2; ++_i) \
        __builtin_amdgcn_global_load_lds((const unsigned*)((const char*)(gbase) + (voff)[_i]), (LAS unsigned*)(lds + (bufoff) + ldsw + _i * 8192), 16, 0, 0); } while (0)
#define PG8_LDA(dst, b, h) do { _Pragma("unroll") for (int m = 0; m < 4; ++m) _Pragma("unroll") for (int k = 0; k < 2; ++k) dst[m][k] = *(const LAS h8*)(lds + PG8_SA(b, h) + aoff + m * 2048 + k * 1024); } while (0)
#define PG8_LDB(dst, b, h) do { _Pragma("unroll") for (int n = 0; n < 2; ++n) _Pragma("unroll") for (int k = 0; k < 2; ++k) dst[n][k] = *(const LAS h8*)(lds + PG8_SB(b, h) + boff + n * 2048 + k * 1024); } while (0)
#define PG8_MMA(ai, bj, At, Bt) do { __builtin_amdgcn_s_setprio(1); _Pragma("unroll") for (int m = 0; m < 4; ++m) _Pragma("unroll") for (int n = 0; n < 2; ++n) _Pragma("unroll") for (int k = 0; k < 2; ++k) \
        acc[ai][bj][m][n] = __builtin_amdgcn_mfma_f32_16x16x32_f16(Bt[n][k], At[m][k], acc[ai][bj][m][n], 0, 0, 0); __builtin_amdgcn_s_setprio(0); } while (0)
#define PG8_WAIT_V(n) asm volatile("s_waitcnt vmcnt(" #n ")" ::: "memory")
#define PG8_WAIT_L(n) asm volatile("s_waitcnt lgkmcnt(" #n ")" ::: "memory")
#define PG8_BAR __builtin_amdgcn_s_barrier()
#define PG8_SCHED __builtin_amdgcn_sched_barrier(0)
    Unit cur, nxt; int ui = 0;
    if (!sched_next(p, kind, l, 0, cur, bid)) return;
    f32x4 acc[2][2][4][2];
#pragma unroll
    for (int a = 0; a < 2; ++a)
#pragma unroll
        for (int b = 0; b < 2; ++b)
#pragma unroll
            for (int m = 0; m < 4; ++m)
#pragma unroll
                for (int n = 0; n < 2; ++n) acc[a][b][m][n] = (f32x4){0.f, 0.f, 0.f, 0.f};
    h8 At[4][2], B0[2][2], B1[2][2];
    const char* cA = cur.A; const char* cB = cur.B;
    PG8_STAGE(PG8_SB(0, 0), cB, voffB); PG8_STAGE(PG8_SA(0, 0), cA, voffA); PG8_STAGE(PG8_SB(0, 1), cB + hstep, voffB); PG8_STAGE(PG8_SA(0, 1), cA + hstep, voffA);
    if (wr == 1) PG8_BAR;
    PG8_WAIT_V(4); PG8_BAR;
    PG8_STAGE(PG8_SB(1, 0), cB + kstep, voffB); PG8_STAGE(PG8_SA(1, 0), cA + kstep, voffA); PG8_STAGE(PG8_SB(1, 1), cB + hstep + kstep, voffB);
    PG8_WAIT_V(6); PG8_BAR;
    for (;;) {
        const bool has_next = sched_next(p, kind, l, ui + 1, nxt, bid);
        const char* nA = has_next ? nxt.A : cA; const char* nB = has_next ? nxt.B : cB;
        for (int t = 0; t < nt; t += 2) {
            const bool last = (t == nt - 2);
            const char* a1 = cA + (size_t)(t + 1) * kstep;
            const char* a2 = last ? nA : cA + (size_t)(t + 2) * kstep; const char* b2 = last ? nB : cB + (size_t)(t + 2) * kstep;
            const char* a3 = a2 + kstep; const char* b3 = b2 + kstep;
            PG8_LDB(B0, 0, 0); PG8_SCHED; PG8_LDA(At, 0, 0); PG8_STAGE(PG8_SA(1, 1), a1 + hstep, voffA);
            PG8_WAIT_L(8); PG8_BAR; PG8_WAIT_L(0); PG8_MMA(0, 0, At, B0); PG8_BAR; PG8_SCHED;
            PG8_LDB(B1, 0, 1); PG8_STAGE(PG8_SB(0, 0), b2, voffB);
            PG8_BAR; PG8_WAIT_L(0); PG8_MMA(0, 1, At, B1); PG8_BAR;
            PG8_LDA(At, 0, 1); PG8_STAGE(PG8_SA(0, 0), a2, voffA);
            PG8_BAR; PG8_WAIT_L(0); PG8_MMA(1, 0, At, B0); PG8_BAR; PG8_SCHED;
            PG8_STAGE(PG8_SB(0, 1), b2 + hstep, voffB);
            PG8_WAIT_V(6); PG8_BAR; PG8_MMA(1, 1, At, B1); PG8_BAR;
            PG8_LDB(B0, 1, 0); PG8_SCHED; PG8_LDA(At, 1, 0); PG8_STAGE(PG8_SA(0, 1), a2 + hstep, voffA);
            PG8_WAIT_L(8); PG8_BAR; PG8_WAIT_L(0); PG8_MMA(0, 0, At, B0); PG8_BAR; PG8_SCHED;
            PG8_LDB(B1, 1, 1); PG8_STAGE(PG8_SB(1, 0), b3, voffB);
            PG8_BAR; PG8_WAIT_L(0); PG8_MMA(0, 1, At, B1); PG8_BAR;
            PG8_LDA(At, 1, 1); PG8_STAGE(PG8_SA(1, 0), a3, voffA);
            PG8_BAR; PG8_WAIT_L(0); PG8_MMA(1, 0, At, B0); PG8_BAR; PG8_SCHED;
            PG8_STAGE(PG8_SB(1, 1), b3 + hstep, voffB);
            PG8_WAIT_V(6); PG8_BAR; PG8_MMA(1, 1, At, B1); PG8_BAR;
        }
        epilogue(p, kind, l, ch, cur, acc, wr, wc, fr, fq);
        if (!has_next) break;
        if (kind != K_MERGE || cur.aux == 2)
#pragma unroll
        for (int a = 0; a < 2; ++a)
#pragma unroll
            for (int b = 0; b < 2; ++b)
#pragma unroll
                for (int m = 0; m < 4; ++m)
#pragma unroll
                    for (int n = 0; n < 2; ++n) acc[a][b][m][n] = (f32x4){0.f, 0.f, 0.f, 0.f};
        cur = nxt; cA = nA; cB = nB; ++ui;
    }
    PG8_WAIT_V(0);
    if (wr == 0) PG8_BAR;
    PG8_BAR;
#undef PG8_SA
#undef PG8_SB
#undef PG8_STAGE
#undef PG8_LDA
#undef PG8_LDB
#undef PG8_MMA
#undef PG8_WAIT_V
#undef PG8_WAIT_L
#undef PG8_BAR
#undef PG8_SCHED
}

constexpr int N_PHASES = 1 + DEPTH * NCH * 5 + 1;

__global__ void __launch_bounds__(NTHREADS, 2) fwd_megakernel(Params p) {
    extern __shared__ __attribute__((aligned(16))) unsigned char lds_raw[];
    LAS unsigned char* lds = (LAS unsigned char*)lds_raw;
    cg::grid_group grid = cg::this_grid();
    for (int ph = p.ph_lo; ph < p.ph_hi; ++ph) {
        int tid = threadIdx.x, bid = blockIdx.x;
#define LAUNDER() do { asm volatile("" : "+v"(tid)); asm volatile("" : "+s"(bid)); } while (0)
        LAUNDER();
        if (ph == 0) {
            for (int rep = 0; rep < 1 + REP_P0; ++rep) { LAUNDER(); p0_prologue(p, lds, tid, bid); }
        } else if (ph == N_PHASES - 1) {
            pf_final(p, tid, bid);
        } else {
            const int q = ph - 1, s = q % 5, lc = q / 5, ch = lc % NCH, l = lc / NCH;
            if (s == 0) p1_norm(p, l, ch, tid, bid);
            else if (s == 1) { for (int rep = 0; rep < 1 + REP_P2; ++rep) { LAUNDER(); gemm_phase(p, lds, K_IN, l, ch, 1024, tid, bid); } }
            else if (s == 2) {
                for (int rep = REP_DFT; rep >= 0; --rep) { LAUNDER();
                    gemm_phase(p, lds, K_DFT, l, ch | (rep ? 0x100 : 0), 8192, tid, bid);
                    if (l < DEPTH - 1) gemm_phase(p, lds, K_CDFT, l, ch | (rep ? 0x100 : 0), 512, tid, bid);
                }
                p3_conv(p, l, tid, bid);
                for (int rep = REP_ATT; rep >= 0; --rep) { LAUNDER(); p3_attn(p, l, (LAS float*)(lds + LDS_STAGE), tid, bid, rep != 0); }
            }
            else if (s == 3) { for (int rep = 0; rep < 1 + REP_P4; ++rep) { LAUNDER(); gemm_phase(p, lds, K_MERGE, l, ch, 512, tid, bid); } }
            else gemm_phase(p, lds, K_OUT, l, ch, 1024, tid, bid);
        }
        if (ph + 1 < p.ph_hi) grid.sync();
    }
}

extern "C" void kernel_launch(void* const* d_in, const int* in_sizes, int n_in, void* d_out, int out_size, void* d_ws, size_t ws_size, hipStream_t stream) {
    static int grid_blocks = 0;
    if (!grid_blocks) {
        int dev = 0, cus = 0, per_cu = 0;
        hipGetDevice(&dev);
        hipDeviceGetAttribute(&cus, hipDeviceAttributeMultiprocessorCount, dev);
        if (hipFuncSetAttribute((const void*)fwd_megakernel, hipFuncAttributeMaxDynamicSharedMemorySize, LDS_BYTES) != hipSuccess) fprintf(stderr, "kernel_launch: hipFuncSetAttribute failed\n");
        hipOccupancyMaxActiveBlocksPerMultiprocessor(&per_cu, (const void*)fwd_megakernel, NTHREADS, LDS_BYTES);
        if (per_cu < 1) { fprintf(stderr, "kernel_launch: occupancy query says %d blocks/CU\n", per_cu); per_cu = 1; }
        (void)hipGetLastError();
        grid_blocks = cus * per_cu;
        if (ws_size < WS_END) fprintf(stderr, "kernel_launch: workspace too small: %zu < %zu\n", ws_size, (size_t)WS_END);
    }
    Params p{};
    const float** f = (const float**)&p;
    for (int i = 0; i < 17; ++i) f[i] = (const float*)d_in[i];
    p.out = (float*)d_out; p.ws = (unsigned char*)d_ws;
#if MULTI_LAUNCH
    for (int ph = 0; ph < N_PHASES; ++ph) {
        p.ph_lo = ph; p.ph_hi = ph + 1;
        hipLaunchKernelGGL(fwd_megakernel, dim3(grid_blocks), dim3(NTHREADS), LDS_BYTES, stream, p);
    }
#else
    p.ph_lo = 0; p.ph_hi = N_PHASES;
    void* args[] = {&p};
    hipError_t e = hipLaunchCooperativeKernel((const void*)fwd_megakernel, dim3(grid_blocks), dim3(NTHREADS), args, LDS_BYTES, stream);
    if (e != hipSuccess) fprintf(stderr, "cooperative launch failed: %s (grid %d)\n", hipGetErrorString(e), grid_blocks);
#endif
}
```

```cpp
#include <hip/hip_runtime.h>
#include <hip/hip_cooperative_groups.h>
#include <cstdio>
namespace cg = cooperative_groups;

#define LAS __attribute__((address_space(3)))
typedef _Float16 h16;
typedef _Float16 h8 __attribute__((ext_vector_type(8)));
typedef _Float16 h4 __attribute__((ext_vector_type(4)));
typedef float f32x4 __attribute__((ext_vector_type(4)));

#ifndef MULTI_LAUNCH
#define MULTI_LAUNCH 0
#endif
#define REP_P0 0
#define REP_P2 0
#define REP_DFT 0
#define REP_ATT 0
#define REP_P4 0

constexpr int DM = 1024, NBATCH = 16, SEQ = 4096, DEPTH = 4, CTXL = 256, DIN = 8192;
constexpr int BC = 8, NCH = 2;
constexpr int TL = BC * SEQ, TX = BC * CTXL, TC = TL + TX;
constexpr int NIN = 8704;
constexpr int NTHREADS = 512;
constexpr int LDS_STAGE = 131072, LDS_BYTES = LDS_STAGE + 16384;

constexpr size_t al256(size_t x) { return (x + 255) & ~(size_t)255; }
constexpr size_t OFF_WIN = 0;
constexpr size_t OFF_BIN = al256(OFF_WIN + (size_t)DEPTH * NIN * 1024 * 2);
constexpr size_t OFF_WBR = al256(OFF_BIN + (size_t)DEPTH * NIN * 4);
constexpr size_t OFF_WOUT = al256(OFF_WBR + (size_t)DEPTH * 3 * 1024 * 512 * 2);
constexpr size_t OFF_CS = al256(OFF_WOUT + (size_t)DEPTH * 1024 * 1024 * 2);
constexpr size_t OFF_CS2 = al256(OFF_CS + (size_t)4096 * 8192 * 2);
constexpr size_t OFF_MOD = al256(OFF_CS2 + (size_t)256 * 512 * 2);
constexpr size_t OFF_CTXR = al256(OFF_MOD + (size_t)DEPTH * 17 * 3072 * 4);
constexpr size_t OFF_H = al256(OFF_CTXR + (size_t)NBATCH * CTXL * 1024 * 4);
constexpr size_t OFF_M = al256(OFF_H + (size_t)TC * 1024 * 2);
constexpr size_t SZ512 = (size_t)TC * 512 * 2;
constexpr size_t OFF_CX = al256(OFF_M + (size_t)TC * 1024 * 2);
constexpr size_t OFF_BZ = al256(OFF_CX + SZ512);
constexpr size_t OFF_FZ = al256(OFF_BZ + SZ512);
constexpr size_t OFF_Q = al256(OFF_FZ + SZ512);
constexpr size_t OFF_K = al256(OFF_Q + SZ512);
constexpr size_t OFF_CZ = al256(OFF_K + SZ512);
constexpr size_t OFF_AACT = al256(OFF_CZ + SZ512);
constexpr size_t OFF_G = al256(OFF_AACT + SZ512);
constexpr size_t OFF_VTL = al256(OFF_G + (size_t)TC * 3072 * 2);
constexpr size_t OFF_VTC = al256(OFF_VTL + (size_t)BC * 512 * 8192 * 2);
constexpr size_t OFF_VF = al256(OFF_VTC + (size_t)BC * 512 * 512 * 2);
constexpr size_t WS_END = al256(OFF_VF + SZ512);

struct Params {
    const float *x, *c, *ctx, *c_ctx, *norm_g, *w_ada, *b_ada, *w_in, *b_in, *w_conv, *b_conv, *rpb, *w_br_a, *w_br_f, *w_br_c, *w_out, *final_g;
    float* out; unsigned char* ws; int ph_lo, ph_hi;
};

__device__ __forceinline__ float shx(float v, int m, int lane) { return __int_as_float(__builtin_amdgcn_ds_bpermute((lane ^ m) << 2, __float_as_int(v))); }
__device__ __forceinline__ float silu_f(float v) { return v * __builtin_amdgcn_rcpf(1.f + __expf(-v)); }
__device__ __forceinline__ float sigm_f(float v) { return __builtin_amdgcn_rcpf(1.f + __expf(-v)); }

__device__ __forceinline__ int in_col(int n) {
    const int j = n >> 8, w = n & 255;
    if (j < 4) return (w < 128) ? (128 * j + w) : (1024 + 128 * j + (w - 128));
    if (j < 8) return (w < 128) ? (512 + 128 * (j - 4) + w) : (1536 + 128 * (j - 4) + (w - 128));
    if (j < 10) return 2560 + (j - 8) * 256 + w;
    if (j < 12) return 3072 + (j - 10) * 256 + w;
    if (j < 14) return 3584 + (j - 12) * 256 + w;
    if (j < 16) return 4608 + (j - 14) * 256 + w;
    if (j < 28) return 5120 + (j - 16) * 256 + w;
    return 4096 + (n - 7168);
}

template <bool PERMCOL>
__device__ __forceinline__ void transpose_tile(const int tid, const float* __restrict__ src, int lds_, h16* __restrict__ dst, int ldd, int k0, int n0, LAS float* t) {
    const int a = tid & 63, b = tid >> 6;
    const int col = PERMCOL ? in_col(n0 + a) : (n0 + a);
#pragma unroll
    for (int it = 0; it < 8; ++it) { const int k = b + it * 8; t[k * 65 + a] = src[(size_t)(k0 + k) * lds_ + col]; }
    __syncthreads();
#pragma unroll
    for (int it = 0; it < 8; ++it) { const int n = b + it * 8; dst[(size_t)(n0 + n) * ldd + k0 + a] = (h16)t[a * 65 + n]; }
    __syncthreads();
}

__device__ __forceinline__ void p0_prologue(const Params& p, LAS unsigned char* lds, const int tid, const int bid) {
    const int G = gridDim.x;
    unsigned char* ws = p.ws;
    LAS float* lf = (LAS float*)lds;
    constexpr int N_MOD = DEPTH * 24;
    constexpr int N_TIN = DEPTH * 120 * 16;
    constexpr int N_FOU = DEPTH * 1024;
    constexpr int N_BIAS = DEPTH;
    constexpr int N_TBR = DEPTH * 3 * 16 * 8;
    constexpr int N_TOUT = DEPTH * 16 * 16;
    constexpr int N_CS = 8192;
    constexpr int N_CS2 = 32;
    constexpr int E0 = N_MOD, E1 = E0 + N_TIN, E2 = E1 + N_FOU, E3 = E2 + N_BIAS, E4 = E3 + N_TBR, E5 = E4 + N_TOUT, E6 = E5 + N_CS, E7 = E6 + N_CS2;
    for (int it = bid; it < E7; it += G) {
        if (it < E0) {
            const int l = it / 24, cb = it % 24;
            for (int i = tid; i < 17 * 1024; i += NTHREADS) { const float v = (i < 16 * 1024) ? p.c[i] : p.c_ctx[i - 16 * 1024]; lf[i] = silu_f(v); }
            __syncthreads();
            const int col = cb * 128 + (tid & 127), kq = tid >> 7;
            float acc[17];
#pragma unroll
            for (int j = 0; j < 17; ++j) acc[j] = 0.f;
            const float* wp = p.w_ada + (size_t)l * 1024 * 3072 + col;
            for (int k = kq * 256; k < kq * 256 + 256; ++k) {
                const float w = wp[(size_t)k * 3072];
#pragma unroll
                for (int j = 0; j < 17; ++j) acc[j] += lf[j * 1024 + k] * w;
            }
            LAS float* red = lf + 17 * 1024;
#pragma unroll
            for (int j = 0; j < 17; ++j) red[(kq * 17 + j) * 128 + (tid & 127)] = acc[j];
            __syncthreads();
            float* MOD = (float*)(ws + OFF_MOD);
            for (int i = tid; i < 17 * 128; i += NTHREADS) {
                const int j = i >> 7, cc = i & 127;
                const float s = red[(0 * 17 + j) * 128 + cc] + red[(1 * 17 + j) * 128 + cc] + red[(2 * 17 + j) * 128 + cc] + red[(3 * 17 + j) * 128 + cc];
                MOD[((size_t)l * 17 + j) * 3072 + cb * 128 + cc] = s + p.b_ada[l * 3072 + cb * 128 + cc];
            }
            __syncthreads();
        } else if (it < E1) {
            const int t = it - E0, l = t / (120 * 16), r = t % (120 * 16), nt = r / 16, kt = r % 16;
            transpose_tile<true>(tid, p.w_in + (size_t)l * 1024 * DIN, DIN, (h16*)(ws + OFF_WIN) + (size_t)l * NIN * 1024, 1024, kt * 64, nt * 64, lf);
        } else if (it < E2) {
            const int t = it - E1, l = t >> 10, k = t & 1023;
            lf[tid] = p.w_in[((size_t)l * 1024 + k) * DIN + 2048 + tid];
            if (tid < 128) { lf[512 + tid] = cospif((float)tid * (1.f / 64.f)); lf[640 + tid] = sinpif((float)tid * (1.f / 64.f)); }
            __syncthreads();
            const int g = tid >> 7, kk = tid & 127;
            float re = 0.f, im = 0.f;
            for (int n2 = 0; n2 < 128; ++n2) { const float w = lf[g * 128 + n2]; const int ix = (n2 * kk) & 127; re += w * lf[512 + ix]; im -= w * lf[640 + ix]; }
            h16* W = (h16*)(ws + OFF_WIN) + (size_t)l * NIN * 1024;
            W[(size_t)(7680 + tid) * 1024 + k] = (h16)(re * 0.08838834764831845f);
            W[(size_t)(7680 + 512 + tid) * 1024 + k] = (h16)(im * 0.08838834764831845f);
            __syncthreads();
        } else if (it < E3) {
            const int l = it - E2;
            float* B = (float*)(ws + OFF_BIN) + (size_t)l * NIN;
            const float* bi = p.b_in + (size_t)l * DIN;
            for (int n = tid; n < 7680; n += NTHREADS) B[n] = bi[in_col(n)];
            const int g = tid >> 7, kk = tid & 127;
            float re = 0.f, im = 0.f;
            for (int n2 = 0; n2 < 128; ++n2) { const float w = bi[2048 + g * 128 + n2]; const float ang = (float)((n2 * kk) & 127) * (1.f / 64.f); re += w * cospif(ang); im -= w * sinpif(ang); }
            B[7680 + tid] = re * 0.08838834764831845f; B[7680 + 512 + tid] = im * 0.08838834764831845f;
        } else if (it < E4) {
            const int t = it - E3, lb = t / 128, r = t % 128, nt = r / 8, kt = r % 8, l = lb / 3, br = lb % 3;
            const float* src = (br == 0 ? p.w_br_a : (br == 1 ? p.w_br_f : p.w_br_c)) + (size_t)l * 512 * 1024;
            transpose_tile<false>(tid, src, 1024, (h16*)(ws + OFF_WBR) + (size_t)lb * 1024 * 512, 512, kt * 64, nt * 64, lf);
        } else if (it < E5) {
            const int t = it - E4, l = t / 256, r = t % 256, nt = r / 16, kt = r % 16;
            transpose_tile<false>(tid, p.w_out + (size_t)l * 1024 * 1024, 1024, (h16*)(ws + OFF_WOUT) + (size_t)l * 1024 * 1024, 1024, kt * 64, nt * 64, lf);
        } else if (it < E6) {
            const size_t e0 = ((size_t)(it - E5) * NTHREADS + tid) * 8;
            const int k1 = (int)(e0 >> 13), j0 = (int)(e0 & 8191);
            h8 o;
#pragma unroll
            for (int j = 0; j < 8; ++j) { const int jj = j0 + j, pos = jj & 4095; const float ang = (float)((k1 * pos) & 4095) * (1.f / 2048.f); o[j] = (h16)((jj < 4096) ? cospif(ang) : sinpif(ang)); }
            *(h8*)((h16*)(ws + OFF_CS) + e0) = o;
        } else {
            const size_t e0 = ((size_t)(it - E6) * NTHREADS + tid) * 8;
            const int k1 = (int)(e0 >> 9), j0 = (int)(e0 & 511);
            h8 o;
#pragma unroll
            for (int j = 0; j < 8; ++j) { const int jj = j0 + j, pos = jj & 255; const float ang = (float)((k1 * pos) & 255) * (1.f / 128.f); o[j] = (h16)((jj < 256) ? cospif(ang) : sinpif(ang)); }
            *(h8*)((h16*)(ws + OFF_CS2) + e0) = o;
        }
    }
}

__device__ __forceinline__ void p1_norm(const Params& p, int l, int ch, const int tid, const int bid) {
    const int lane = tid & 63, wid = tid >> 6;
    unsigned char* ws = p.ws;
    const float* xsrc = (l == 0) ? p.x : p.out;
    const float* csrc = (l == 0) ? p.ctx : (const float*)(ws + OFF_CTXR);
    const float* MOD = (const float*)(ws + OFF_MOD) + (size_t)l * 17 * 3072;
    const float* ng = p.norm_g + l * 1024;
    h16* H = (h16*)(ws + OFF_H);
    for (int row = bid * 8 + wid; row < TC; row += gridDim.x * 8) {
        const float* src = (row < TL) ? xsrc + ((size_t)ch * TL + row) * 1024 : csrc + ((size_t)ch * TX + (row - TL)) * 1024;
        const float* mod = MOD + (size_t)((row < TL) ? (ch * BC + (row >> 12)) : 16) * 3072;
        f32x4 v[4]; float ss = 0.f;
#pragma unroll
        for (int it = 0; it < 4; ++it) { v[it] = *(const f32x4*)(src + it * 256 + lane * 4); ss += v[it][0] * v[it][0] + v[it][1] * v[it][1] + v[it][2] * v[it][2] + v[it][3] * v[it][3]; }
#pragma unroll
        for (int o = 32; o >= 1; o >>= 1) ss += shx(ss, o, lane);
        const float inv = rsqrtf(ss * (1.f / 1024.f) + 1e-6f);
#pragma unroll
        for (int it = 0; it < 4; ++it) {
            const int c = it * 256 + lane * 4;
            const f32x4 g = *(const f32x4*)(ng + c), sh = *(const f32x4*)(mod + c), sc = *(const f32x4*)(mod + 1024 + c);
            h4 o;
#pragma unroll
            for (int j = 0; j < 4; ++j) o[j] = (h16)(v[it][j] * inv * g[j] * (1.f + sc[j]) + sh[j]);
            *(h4*)(H + (size_t)row * 1024 + c) = o;
        }
    }
}

__device__ __forceinline__ void pf_final(const Params& p, const int tid, const int bid) {
    const int lane = tid & 63, wid = tid >> 6;
    for (int row = bid * 8 + wid; row < NBATCH * SEQ; row += gridDim.x * 8) {
        float* src = p.out + (size_t)row * 1024;
        f32x4 v[4]; float ss = 0.f;
#pragma unroll
        for (int it = 0; it < 4; ++it) { v[it] = *(const f32x4*)(src + it * 256 + lane * 4); ss += v[it][0] * v[it][0] + v[it][1] * v[it][1] + v[it][2] * v[it][2] + v[it][3] * v[it][3]; }
#pragma unroll
        for (int o = 32; o >= 1; o >>= 1) ss += shx(ss, o, lane);
        const float inv = rsqrtf(ss * (1.f / 1024.f) + 1e-6f);
#pragma unroll
        for (int it = 0; it < 4; ++it) { const int c = it * 256 + lane * 4; const f32x4 g = *(const f32x4*)(p.final_g + c); *(f32x4*)(src + c) = v[it] * inv * g; }
    }
}

__device__ __forceinline__ void p3_conv(const Params& p, int l, const int tid, const int bid) {
    unsigned char* ws = p.ws;
    const h16* CX = (const h16*)(ws + OFF_CX); const h16* BZ = (const h16*)(ws + OFF_BZ); h16* AA = (h16*)(ws + OFF_AACT);
    const float* wc = p.w_conv + (size_t)l * 3 * 512; const float* bc = p.b_conv + (size_t)l * 512;
    const int nrows = (l == DEPTH - 1) ? TL : TC;
    for (int idx = bid * NTHREADS + tid; idx < nrows * 64; idx += gridDim.x * NTHREADS) {
        const int row = idx >> 6, c8 = (idx & 63) * 8;
        const int pos = (row < TL) ? (row & 4095) : ((row - TL) & 255), L = (row < TL) ? 4096 : 256;
        const h8 z = {0, 0, 0, 0, 0, 0, 0, 0};
        const h8 cur = *(const h8*)(CX + (size_t)row * 512 + c8);
        const h8 prv = (pos > 0) ? *(const h8*)(CX + (size_t)(row - 1) * 512 + c8) : z;
        const h8 nxt = (pos < L - 1) ? *(const h8*)(CX + (size_t)(row + 1) * 512 + c8) : z;
        const h8 bz = *(const h8*)(BZ + (size_t)row * 512 + c8);
        h8 o;
#pragma unroll
        for (int j = 0; j < 8; ++j) {
            const float cv = wc[c8 + j] * (float)prv[j] + wc[512 + c8 + j] * (float)cur[j] + wc[1024 + c8 + j] * (float)nxt[j] + bc[c8 + j];
            o[j] = (h16)((float)bz[j] * cv);
        }
        *(h8*)(AA + (size_t)row * 512 + c8) = o;
    }
}

__device__ __forceinline__ const h16* katt(const h16* Kb, int keytok, int h, int fq) { return Kb + ((size_t)((keytok >> 3) * 8 + h) * 8 + fq) * 64 + (keytok & 7) * 8; }
__device__ __forceinline__ const h16* vatt(const h16* VF, int tk, int h, int dt, int fr) { return VF + ((size_t)((tk >> 3) * 8 + h) * 4 + dt) * 128 + (((tk >> 2) & 1) * 16 + fr) * 4; }

template <bool LAT>
__device__ __forceinline__ void attn_unit(const h16* Qb, const h16* Kb, const h16* VF, h16* CZ, const LAS float* rpbL, const int bb, const int h, const int r, const int n, const int tokQ0, const int fr, const int fq, const int lane, const bool dummy) {
    constexpr int NT = LAT ? 32 : 16, NKB = NT / 4, NP = NT / 2, NVB = NP / 4;
    const f32x4 zero4 = {0.f, 0.f, 0.f, 0.f};
    const int tokQ = tokQ0 + fr;
    const h16* qp = Qb + (size_t)tokQ * 512 + h * 64 + fq * 8;
    const h8 q0 = *(const h8*)qp, q1 = *(const h8*)(qp + 32);
    int kcs = n * 16 - 8; kcs = kcs < 0 ? 0 : (kcs > 32 ? 32 : kcs);
    int rs = r - 4; rs = rs < 0 ? 0 : (rs > 56 ? 56 : rs);
    const int qcol = n * 16 + fr; int cs = qcol - 8; cs = cs < 0 ? 0 : (cs > 48 ? 48 : cs);
#define ATT_TOK(t) ((LAT && (t) < 16) ? (bb * 4096 + (rs + ((t) >> 1)) * 64 + kcs + 16 * ((t) & 1)) : (TL + bb * 256 + ((t) - (LAT ? 16 : 0)) * 16))
    f32x4 s[NT];
    h8 kb[2][4][2];
#pragma unroll
    for (int tt = 0; tt < 4; ++tt) { const h16* kp = katt(Kb, ATT_TOK(tt) + fr, h, fq); kb[0][tt][0] = *(const h8*)kp; kb[0][tt][1] = *(const h8*)(kp + 256); }
#pragma unroll
    for (int b = 0; b < NKB; ++b) {
        if (b + 1 < NKB) {
#pragma unroll
            for (int tt = 0; tt < 4; ++tt) { const int t = (b + 1) * 4 + tt; const h16* kp = katt(Kb, ATT_TOK(t) + fr, h, fq); kb[(b + 1) & 1][tt][0] = *(const h8*)kp; kb[(b + 1) & 1][tt][1] = *(const h8*)(kp + 256); }
        }
        __builtin_amdgcn_sched_barrier(0);
#pragma unroll
        for (int tt = 0; tt < 4; ++tt) {
            const int t = b * 4 + tt;
            f32x4 a = zero4;
            a = __builtin_amdgcn_mfma_f32_16x16x32_f16(kb[b & 1][tt][0], q0, a, 0, 0, 0);
            a = __builtin_amdgcn_mfma_f32_16x16x32_f16(kb[b & 1][tt][1], q1, a, 0, 0, 0);
            if (LAT && t < 16) {
                const int i = t >> 1, par = t & 1;
                const int kc0 = kcs + 16 * par + 4 * fq;
                const LAS float* bp = rpbL + (h * 15 + (rs + i - r + 7)) * 31;
#pragma unroll
                for (int j = 0; j < 4; ++j) {
                    const int kcol = kc0 + j; const bool ok = (kcol >= cs) && (kcol < cs + 16);
                    int dc = kcol - qcol + 15; dc = dc < 0 ? 0 : (dc > 30 ? 30 : dc);
                    a[j] = ok ? a[j] + bp[dc] : -1e30f;
                }
            }
            s[t] = a;
        }
        __builtin_amdgcn_sched_barrier(0);
    }
    h4 vb[2][4][4][2];
#pragma unroll
    for (int pp = 0; pp < 4; ++pp)
#pragma unroll
        for (int dt = 0; dt < 4; ++dt) { const int tk = ATT_TOK(2 * pp) + 4 * fq; vb[0][pp][dt][0] = *(const h4*)vatt(VF, tk, h, dt, fr); vb[0][pp][dt][1] = *(const h4*)vatt(VF, tk + 16, h, dt, fr); }
    __builtin_amdgcn_sched_barrier(0);
    float mx = -3e38f;
#pragma unroll
    for (int t = 0; t < NT; ++t) mx = fmaxf(mx, fmaxf(fmaxf(s[t][0], s[t][1]), fmaxf(s[t][2], s[t][3])));
    mx = fmaxf(mx, shx(mx, 16, lane)); mx = fmaxf(mx, shx(mx, 32, lane));
    float sum = 0.f;
    h8 pf[NP];
#pragma unroll
    for (int tp = 0; tp < NP; ++tp) {
#pragma unroll
        for (int j = 0; j < 4; ++j) {
            const float e0 = __expf(s[2 * tp][j] - mx), e1 = __expf(s[2 * tp + 1][j] - mx);
            sum += e0 + e1; pf[tp][j] = (h16)e0; pf[tp][4 + j] = (h16)e1;
        }
    }
    sum += shx(sum, 16, lane); sum += shx(sum, 32, lane);
    f32x4 o[4] = {zero4, zero4, zero4, zero4};
#pragma unroll
    for (int b = 0; b < NVB; ++b) {
        if (b + 1 < NVB) {
#pragma unroll
            for (int pp = 0; pp < 4; ++pp)
#pragma unroll
                for (int dt = 0; dt < 4; ++dt) { const int tk = ATT_TOK(2 * ((b + 1) * 4 + pp)) + 4 * fq; vb[(b + 1) & 1][pp][dt][0] = *(const h4*)vatt(VF, tk, h, dt, fr); vb[(b + 1) & 1][pp][dt][1] = *(const h4*)vatt(VF, tk + 16, h, dt, fr); }
        }
        __builtin_amdgcn_sched_barrier(0);
#pragma unroll
        for (int pp = 0; pp < 4; ++pp)
#pragma unroll
            for (int dt = 0; dt < 4; ++dt) {
                const h4 v0 = vb[b & 1][pp][dt][0], v1 = vb[b & 1][pp][dt][1];
                const h8 vf = {v0[0], v0[1], v0[2], v0[3], v1[0], v1[1], v1[2], v1[3]};
                o[dt] = __builtin_amdgcn_mfma_f32_16x16x32_f16(vf, pf[b * 4 + pp], o[dt], 0, 0, 0);
            }
        __builtin_amdgcn_sched_barrier(0);
    }
#undef ATT_TOK
    const float inv = 1.f / sum;
#pragma unroll
    for (int dt = 0; dt < 4; ++dt) {
        h16* cp = CZ + (size_t)tokQ * 512 + h * 64 + 16 * dt + 4 * fq;
        const h4 cz = *(const h4*)cp; h4 ov;
#pragma unroll
        for (int j = 0; j < 4; ++j) ov[j] = (h16)(o[dt][j] * inv * (float)cz[j]);
        if (dummy) cp = (h16*)((char*)cp - (OFF_CZ - OFF_H));
        *(h4*)cp = ov;
    }
}

__device__ __forceinline__ void p3_attn(const Params& p, int l, LAS float* rpbL, const int tid, const int bid, const bool dummy) {
    const int lane = tid & 63, wid = tid >> 6, fr = lane & 15, fq = lane >> 4;
    unsigned char* ws = p.ws;
    const h16* Qb = (const h16*)(ws + OFF_Q); const h16* Kb = (const h16*)(ws + OFF_K);
    const h16* VF = (const h16*)(ws + OFF_VF);
    h16* CZ = (h16*)(ws + OFF_CZ);
    for (int i = tid; i < 8 * 15 * 31; i += NTHREADS) rpbL[i] = p.rpb[(size_t)l * 8 * 15 * 31 + i];
    __syncthreads();
    for (int u = bid * 8 + wid; u < BC * 8 * 64 * 4; u += gridDim.x * 8) {
        const int n = u & 3, r = (u >> 2) & 63, h = (u >> 8) & 7, bb = u >> 11;
        attn_unit<true>(Qb, Kb, VF, CZ, rpbL, bb, h, r, n, bb * 4096 + r * 64 + n * 16, fr, fq, lane, dummy);
    }
    if (l < DEPTH - 1) {
        for (int u = bid * 8 + wid; u < BC * 8 * 16; u += gridDim.x * 8) {
            const int qg = u & 15, h = (u >> 4) & 7, bb = u >> 7;
            attn_unit<false>(Qb, Kb, VF, CZ, rpbL, bb, h, 0, 0, TL + bb * 256 + qg * 16, fr, fq, lane, dummy);
        }
    }
}

constexpr int BM = 256, BK = 64, HALF = 128, HTB = HALF * BK * 2;
enum { K_IN = 0, K_DFT = 1, K_CDFT = 2, K_MERGE = 3, K_OUT = 4 };
struct Unit { const char* A; const char* B; int pm, pn, aux; };

__device__ __forceinline__ int lds_byte(int r, int c) { const int st = (r >> 4) * 2 + (c >> 5), rr = r & 15, cc = c & 31, ob = rr * 64 + cc * 2; return st * 1024 + (ob ^ (((ob >> 9) & 1) << 5)); }
__device__ __forceinline__ void stage_rc(int b, int& R, int& C) { const int st = b / 1024, sb = b % 1024, swz = sb ^ (((sb >> 9) & 1) << 5); R = (st >> 1) * 16 + swz / 64; C = (st & 1) * 32 + (swz % 64) / 2; }
__device__ __forceinline__ int perm32(int rho) { const int n = rho >> 4, i = rho & 15; return 8 * (i >> 2) + 4 * n + (i & 3); }

__device__ __forceinline__ bool sched_next(const Params& p, const int kind, const int l, const int i, Unit& u, const int bid) {
    const int G = gridDim.x, c = bid;
    const char* ws = (const char*)p.ws;
    if (kind == K_IN) {
        constexpr int nM = TC / 256, nN = NIN / 256, nwg = nM * nN;
        const long L = (long)i * G + c; if (L >= nwg) return false;
        int wgid = (int)L; { const int q = nwg / 8, r = nwg % 8, xcd = wgid % 8, off = wgid / 8; wgid = (xcd < r ? xcd * (q + 1) : r * (q + 1) + (xcd - r) * q) + off; }
        const int nig = 8 * nN, gid = wgid / nig, fm = gid * 8, gsz = (nM - fm) < 8 ? (nM - fm) : 8;
        const int pm = fm + ((wgid % nig) % gsz), pn = (wgid % nig) / gsz;
        const char* Hp = ws + OFF_H + (size_t)pm * 256 * 1024 * 2;
        const char* Wp = ws + OFF_WIN + ((size_t)l * NIN + pn * 256) * 1024 * 2;
        if (pn < 28) { u.A = Hp; u.B = Wp; } else { u.A = Wp; u.B = Hp; }
        u.pm = pm; u.pn = pn; u.aux = 0; return true;
    } else if (kind == K_DFT) {
        const int L = i * G + c; if (L >= BC * 32) return false;
        const int bb = L & 7, j = L >> 3, pm = j >> 1, pn = j & 1;
        u.A = ws + OFF_CS + (size_t)pm * 256 * 8192 * 2; u.B = ws + OFF_VTL + ((size_t)(bb * 512 + pn * 256)) * 8192 * 2;
        u.pm = pm; u.pn = pn; u.aux = bb; return true;
    } else if (kind == K_CDFT) {
        const int L = i * G + c; if (L >= BC * 2) return false;
        const int bb = L >> 1, pn = L & 1;
        u.A = ws + OFF_CS2; u.B = ws + OFF_VTC + ((size_t)(bb * 512 + pn * 256)) * 512 * 2;
        u.pm = 0; u.pn = pn; u.aux = bb; return true;
    } else if (kind == K_MERGE) {
        const int ntile = ((l == DEPTH - 1) ? TL / 256 : TC / 256) * 4;
        const int ti = (i / 3) * G + c, br = i % 3; if (ti >= ntile) return false;
        const int pm = ti >> 2, pn = ti & 3;
        const size_t aoff = (br == 0) ? OFF_AACT : (br == 1 ? OFF_FZ : OFF_CZ);
        u.A = ws + aoff + (size_t)pm * 256 * 512 * 2; u.B = ws + OFF_WBR + ((size_t)((l * 3 + br) * 1024 + pn * 256)) * 512 * 2;
        u.pm = pm; u.pn = pn; u.aux = br; return true;
    } else {
        const int ntile = ((l == DEPTH - 1) ? TL / 256 : TC / 256) * 4;
        const int ti = i * G + c; if (ti >= ntile) return false;
        const int pm = ti >> 2, pn = ti & 3;
        u.A = ws + OFF_M + (size_t)pm * 256 * 1024 * 2; u.B = ws + OFF_WOUT + ((size_t)(l * 1024 + pn * 256)) * 1024 * 2;
        u.pm = pm; u.pn = pn; u.aux = 0; return true;
    }
}

__device__ __forceinline__ void epilogue(const Params& p, const int kind, const int l, const int ch, const Unit& u, f32x4 (&acc)[2][2][4][2], int wr, int wc, int fr, int fq) {
    unsigned char* ws = p.ws;
    const int cw = wc * 32 + 8 * fq, rl0 = wr * 64 + fr;
    const int pm = u.pm, pn = u.pn;
    if (kind == K_IN) {
        const float* bias = (const float*)(ws + OFF_BIN) + (size_t)l * NIN + pn * 256;
        if (pn < 8) {
            f32x4 b[2][2];
#pragma unroll
            for (int bj = 0; bj < 2; ++bj)
#pragma unroll
                for (int n = 0; n < 2; ++n) b[bj][n] = *(const f32x4*)(bias + 128 * bj + cw + 4 * n);
            h16* dst = (h16*)(ws + (pn < 4 ? OFF_CX : OFF_BZ)) + (size_t)(pm * 256 + rl0) * 512 + 128 * (pn & 3) + cw;
            const bool mul = pn < 4;
#pragma unroll
            for (int ai = 0; ai < 2; ++ai)
#pragma unroll
                for (int m = 0; m < 4; ++m) {
                    h8 o;
#pragma unroll
                    for (int n = 0; n < 2; ++n)
#pragma unroll
                        for (int j = 0; j < 4; ++j) {
                            const float v0 = acc[ai][0][m][n][j] + b[0][n][j], v1 = acc[ai][1][m][n][j] + b[1][n][j];
                            o[4 * n + j] = (h16)(mul ? v0 * v1 : v0 * silu_f(v1));
                        }
                    *(h8*)(dst + (size_t)(128 * ai + 16 * m) * 512) = o;
                }
        } else if (pn < 28) {
            f32x4 b[2][2];
#pragma unroll
            for (int bj = 0; bj < 2; ++bj)
#pragma unroll
                for (int n = 0; n < 2; ++n) b[bj][n] = *(const f32x4*)(bias + 128 * bj + cw + 4 * n);
            size_t off; int ld, oc, act;
            if (pn < 10) { off = OFF_FZ; ld = 512; oc = (pn - 8) * 256; act = 1; }
            else if (pn < 12) { off = OFF_Q; ld = 512; oc = (pn - 10) * 256; act = 3; }
            else if (pn < 14) { off = OFF_K; ld = 512; oc = (pn - 12) * 256; act = 0; }
            else if (pn < 16) { off = OFF_CZ; ld = 512; oc = (pn - 14) * 256; act = 1; }
            else { off = OFF_G; ld = 3072; oc = (pn - 16) * 256; act = 2; }
            h16* dst = (h16*)(ws + off) + (size_t)(pm * 256 + rl0) * ld + oc + cw;
            const bool isk = (pn == 12 || pn == 13);
#pragma unroll
            for (int ai = 0; ai < 2; ++ai)
#pragma unroll
                for (int m = 0; m < 4; ++m)
#pragma unroll
                    for (int bj = 0; bj < 2; ++bj) {
                        h8 o;
#pragma unroll
                        for (int n = 0; n < 2; ++n)
#pragma unroll
                            for (int j = 0; j < 4; ++j) {
                                float v = acc[ai][bj][m][n][j] + b[bj][n][j];
                                if (act == 1) v = silu_f(v); else if (act == 2) v = fmaxf(sigm_f(v), 6.2e-5f); else if (act == 3) v *= 0.125f;
                                o[4 * n + j] = (h16)v;
                            }
                        h16* q = dst + (size_t)(128 * ai + 16 * m) * ld + 128 * bj;
                        if (isk) {
                            const int tok = pm * 256 + 128 * ai + 16 * m + rl0, col = (pn - 12) * 256 + 128 * bj + cw;
                            q = (h16*)(ws + OFF_K) + ((size_t)((tok >> 3) * 8 + (col >> 6)) * 8 + ((col & 63) >> 3)) * 64 + (tok & 7) * 8;
                        }
                        *(h8*)q = o;
                    }
        } else {
            const bool lat = pm < TL / 256;
            const int bb = lat ? (pm >> 4) : (pm - TL / 256), pos0 = lat ? (pm & 15) * 256 : 0;
            if (pn < 30) {
                h16* VF = (h16*)(ws + OFF_VF);
#pragma unroll
                for (int ai = 0; ai < 2; ++ai)
#pragma unroll
                    for (int m = 0; m < 4; ++m) {
                        const int rt = 128 * ai + 16 * m + rl0, chn = (pn - 28) * 256 + rt;
                        const float bv = bias[rt];
#pragma unroll
                        for (int bj = 0; bj < 2; ++bj) {
                            const int t8 = (pm * 256 + 128 * bj + cw) >> 3;
                            h16* q = VF + ((size_t)(t8 * 8 + (chn >> 6)) * 4 + ((chn & 63) >> 4)) * 128 + (chn & 15) * 4;
                            h4 o0, o1;
#pragma unroll
                            for (int j = 0; j < 4; ++j) { o0[j] = (h16)(acc[ai][bj][m][0][j] + bv); o1[j] = (h16)(acc[ai][bj][m][1][j] + bv); }
                            *(h4*)q = o0; *(h4*)(q + 64) = o1;
                        }
                    }
            } else {
                h16* dst; int ld;
                const int part = (pn - 30) >> 1, c0 = ((pn - 30) & 1) * 256;
                if (lat) { dst = (h16*)(ws + OFF_VTL) + ((size_t)(bb * 512 + c0)) * 8192 + part * 4096 + pos0; ld = 8192; }
                else { dst = (h16*)(ws + OFF_VTC) + ((size_t)(bb * 512 + c0)) * 512 + part * 256; ld = 512; }
#pragma unroll
                for (int ai = 0; ai < 2; ++ai)
#pragma unroll
                    for (int m = 0; m < 4; ++m) {
                        const int rt = 128 * ai + 16 * m + rl0;
                        const float bv = bias[rt];
#pragma unroll
                        for (int bj = 0; bj < 2; ++bj) {
                            h8 o;
#pragma unroll
                            for (int n = 0; n < 2; ++n)
#pragma unroll
                                for (int j = 0; j < 4; ++j) o[4 * n + j] = (h16)(acc[ai][bj][m][n][j] + bv);
                            *(h8*)(dst + (size_t)rt * ld + 128 * bj + cw) = o;
                        }
                    }
            }
        }
    } else if (kind == K_DFT || kind == K_CDFT) {
        const int row0 = (kind == K_DFT) ? (u.aux * 4096 + pm * 256) : (TL + u.aux * 256);
        const float sc = (kind == K_DFT) ? (1.f / 64.f) : (1.f / 16.f);
        h16* dst = (h16*)(ws + OFF_FZ) + (size_t)(row0 + rl0) * 512 + pn * 256 + cw;
#pragma unroll
        for (int ai = 0; ai < 2; ++ai) {
            h8 fz[4][2];
#pragma unroll
            for (int m = 0; m < 4; ++m)
#pragma unroll
                for (int bj = 0; bj < 2; ++bj) fz[m][bj] = *(const h8*)(dst + (size_t)(128 * ai + 16 * m) * 512 + 128 * bj);
#pragma unroll
            for (int m = 0; m < 4; ++m)
#pragma unroll
                for (int bj = 0; bj < 2; ++bj) {
                    h16* q = dst + (size_t)(128 * ai + 16 * m) * 512 + 128 * bj; h8 o;
                    if (ch & 0x100) q = (h16*)((char*)q - (OFF_FZ - OFF_H));
#pragma unroll
                    for (int n = 0; n < 2; ++n)
#pragma unroll
                        for (int j = 0; j < 4; ++j) o[4 * n + j] = (h16)(acc[ai][bj][m][n][j] * sc * (float)fz[m][bj][4 * n + j]);
                    *(h8*)q = o;
                }
            asm volatile("" ::: "memory");
        }
    } else if (kind == K_MERGE) {
        const int br = u.aux;
        const h16* gp = (const h16*)(ws + OFF_G) + (size_t)(pm * 256 + rl0) * 3072 + br * 1024 + pn * 256 + cw;
        h16* mp = (h16*)(ws + OFF_M) + (size_t)(pm * 256 + rl0) * 1024 + pn * 256 + cw;
#pragma unroll
        for (int ai = 0; ai < 2; ++ai) {
            h8 ga[4][2], gb[4][2];
#pragma unroll
            for (int m = 0; m < 4; ++m)
#pragma unroll
                for (int bj = 0; bj < 2; ++bj) {
                    const h16* q = gp + (size_t)(128 * ai + 16 * m) * 3072 + 128 * bj;
                    ga[m][bj] = *(const h8*)q;
                    if (br < 2) gb[m][bj] = *(const h8*)(q + 1024);
                }
#pragma unroll
            for (int m = 0; m < 4; ++m)
#pragma unroll
                for (int bj = 0; bj < 2; ++bj) {
                    if (br < 2) {
#pragma unroll
                        for (int n = 0; n < 2; ++n)
#pragma unroll
                            for (int j = 0; j < 4; ++j) acc[ai][bj][m][n][j] *= (float)ga[m][bj][4 * n + j] * __builtin_amdgcn_rcpf((float)gb[m][bj][4 * n + j]);
                    } else {
                        h8 o;
#pragma unroll
                        for (int n = 0; n < 2; ++n)
#pragma unroll
                            for (int j = 0; j < 4; ++j) o[4 * n + j] = (h16)(acc[ai][bj][m][n][j] * (float)ga[m][bj][4 * n + j]);
                        *(h8*)(mp + (size_t)(128 * ai + 16 * m) * 1024 + 128 * bj) = o;
                    }
                }
            asm volatile("" ::: "memory");
        }
    } else {
        const bool lat = pm < TL / 256;
        const float* res; float* dst; const float* gt;
        const float* MOD = (const float*)(ws + OFF_MOD) + (size_t)l * 17 * 3072 + 2048;
        if (lat) {
            const size_t t0 = ((size_t)ch * TL + pm * 256) * 1024;
            res = ((l == 0) ? p.x : p.out) + t0; dst = p.out + t0; gt = MOD + (size_t)(ch * BC + (pm >> 4)) * 3072;
        } else {
            const size_t t0 = ((size_t)ch * TX + (pm - TL / 256) * 256) * 1024;
            res = ((l == 0) ? p.ctx : (const float*)(ws + OFF_CTXR)) + t0; dst = (float*)(ws + OFF_CTXR) + t0; gt = MOD + (size_t)16 * 3072;
        }
        const int c0 = pn * 256 + cw;
        f32x4 gv[2][2];
#pragma unroll
        for (int bj = 0; bj < 2; ++bj)
#pragma unroll
            for (int n = 0; n < 2; ++n) gv[bj][n] = *(const f32x4*)(gt + c0 + 128 * bj + 4 * n);
#pragma unroll
        for (int ai = 0; ai < 2; ++ai) {
            f32x4 r[4][2][2];
#pragma unroll
            for (int m = 0; m < 4; ++m)
#pragma unroll
                for (int bj = 0; bj < 2; ++bj)
#pragma unroll
                    for (int n = 0; n < 2; ++n) r[m][bj][n] = *(const f32x4*)(res + (size_t)(128 * ai + 16 * m + rl0) * 1024 + c0 + 128 * bj + 4 * n);
#pragma unroll
            for (int m = 0; m < 4; ++m)
#pragma unroll
                for (int bj = 0; bj < 2; ++bj)
#pragma unroll
                    for (int n = 0; n < 2; ++n) *(f32x4*)(dst + (size_t)(128 * ai + 16 * m + rl0) * 1024 + c0 + 128 * bj + 4 * n) = r[m][bj][n] + gv[bj][n] * acc[ai][bj][m][n];
            asm volatile("" ::: "memory");
        }
    }
}

__device__ __forceinline__ void gemm_phase(const Params& p, LAS unsigned char* lds, const int kind, const int l, const int ch, const int K, const int tid, const int bid) {
    const int wid = __builtin_amdgcn_readfirstlane(tid >> 6), lane = tid & 63, wr = wid >> 2, wc = wid & 3, fr = lane & 15, fq = lane >> 4;
    const int nt = K / BK;
    unsigned voffA[2], voffB[2];
#pragma unroll
    for (int i = 0; i < 2; ++i) { int R, C; stage_rc(tid * 16 + i * 8192, R, C); const int Rb = (R & ~31) + perm32(R & 31);
        voffA[i] = (unsigned)(R * K + C) * 2u; voffB[i] = (unsigned)(Rb * K + C) * 2u; }
    const size_t kstep = (size_t)(BK * 2);
    const size_t hstep = (size_t)HALF * K * 2;
    const unsigned ldsw = (unsigned)wid * 1024u;
    const int aoff = lds_byte(wr * 64 + fr, fq * 8), boff = lds_byte(wc * 32 + fr, fq * 8);
#define PG8_SA(b, h) (((b) * 2 + (h)) * HTB)
#define PG8_SB(b, h) ((4 + (b) * 2 + (h)) * HTB)
#define PG8_STAGE(bufoff, gbase, voff) do { _Pragma("unroll") for (int _i = 0; _i < 2; ++_i) \
        __builtin_amdgcn_global_load_lds((const unsigned*)((const char*)(gbase) + (voff)[_i]), (LAS unsigned*)(lds + (bufoff) + ldsw + _i * 8192), 16, 0, 0); } while (0)
#define PG8_LDA(dst, b, h) do { _Pragma("unroll") for (int m = 0; m < 4; ++m) _Pragma("unroll") for (int k = 0; k < 2; ++k) dst[m][k] = *(const LAS h8*)(lds + PG8_SA(b, h) + aoff + m * 2048 + k * 1024); } while (0)
#define PG8_LDB(dst, b, h) do { _Pragma("unroll") for (int n = 0; n < 2; ++n) _Pragma("unroll") for (int k = 0; k < 2; ++k) dst[n][k] = *(const LAS h8*)(lds + PG8_SB(b, h) + boff + n * 2048 + k * 1024); } while (0)
#define PG8_MMA(ai, bj, At, Bt) do { __builtin_amdgcn_s_setprio(1); _Pragma("unroll") for (int m = 0; m < 4; ++m) _Pragma("unroll") for (int n = 0; n < 2; ++n) _Pragma("unroll") for (int k = 0; k < 2; ++k) \
        acc[ai][bj][m][n] = __builtin_amdgcn_mfma_f32_16x16x32_f16(Bt[n][k], At[m][k], acc[ai][bj][m][n], 0, 0, 0); __builtin_amdgcn_s_setprio(0); } while (0)
#define PG8_WAIT_V(n) asm volatile("s_waitcnt vmcnt(" #n ")" ::: "memory")
#define PG8_WAIT_L(n) asm volatile("s_waitcnt lgkmcnt(" #n ")" ::: "memory")
#define PG8_BAR __builtin_amdgcn_s_barrier()
#define PG8_SCHED __builtin_amdgcn_sched_barrier(0)
    Unit cur, nxt; int ui = 0;
    if (!sched_next(p, kind, l, 0, cur, bid)) return;
    f32x4 acc[2][2][4][2];
#pragma unroll
    for (int a = 0; a < 2; ++a)
#pragma unroll
        for (int b = 0; b < 2; ++b)
#pragma unroll
            for (int m = 0; m < 4; ++m)
#pragma unroll
                for (int n = 0; n < 2; ++n) acc[a][b][m][n] = (f32x4){0.f, 0.f, 0.f, 0.f};
    h8 At[4][2], B0[2][2], B1[2][2];
    const char* cA = cur.A; const char* cB = cur.B;
    PG8_STAGE(PG8_SB(0, 0), cB, voffB); PG8_STAGE(PG8_SA(0, 0), cA, voffA); PG8_STAGE(PG8_SB(0, 1), cB + hstep, voffB); PG8_STAGE(PG8_SA(0, 1), cA + hstep, voffA);
    if (wr == 1) PG8_BAR;
    PG8_WAIT_V(4); PG8_BAR;
    PG8_STAGE(PG8_SB(1, 0), cB + kstep, voffB); PG8_STAGE(PG8_SA(1, 0), cA + kstep, voffA); PG8_STAGE(PG8_SB(1, 1), cB + hstep + kstep, voffB);
    PG8_WAIT_V(6); PG8_BAR;
    for (;;) {
        const bool has_next = sched_next(p, kind, l, ui + 1, nxt, bid);
        const char* nA = has_next ? nxt.A : cA; const char* nB = has_next ? nxt.B : cB;
        for (int t = 0; t < nt; t += 2) {
            const bool last = (t == nt - 2);
            const char* a1 = cA + (size_t)(t + 1) * kstep;
            const char* a2 = last ? nA : cA + (size_t)(t + 2) * kstep; const char* b2 = last ? nB : cB + (size_t)(t + 2) * kstep;
            const char* a3 = a2 + kstep; const char* b3 = b2 + kstep;
            PG8_LDB(B0, 0, 0); PG8_SCHED; PG8_LDA(At, 0, 0); PG8_STAGE(PG8_SA(1, 1), a1 + hstep, voffA);
            PG8_WAIT_L(8); PG8_BAR; PG8_WAIT_L(0); PG8_MMA(0, 0, At, B0); PG8_BAR; PG8_SCHED;
            PG8_LDB(B1, 0, 1); PG8_STAGE(PG8_SB(0, 0), b2, voffB);
            PG8_BAR; PG8_WAIT_L(0); PG8_MMA(0, 1, At, B1); PG8_BAR;
            PG8_LDA(At, 0, 1); PG8_STAGE(PG8_SA(0, 0), a2, voffA);
            PG8_BAR; PG8_WAIT_L(0); PG8_MMA(1, 0, At, B0); PG8_BAR; PG8_SCHED;
            PG8_STAGE(PG8_SB(0, 1), b2 + hstep, voffB);
            PG8_WAIT_V(6); PG8_BAR; PG8_MMA(1, 1, At, B1); PG8_BAR;
            PG8_LDB(B0, 1, 0); PG8_SCHED; PG8_LDA(At, 1, 0); PG8_STAGE(PG8_SA(0, 1), a2 + hstep, voffA);
            PG8_WAIT_L(8); PG8_BAR; PG8_WAIT_L(0); PG8_MMA(0, 0, At, B0); PG8_BAR; PG8_SCHED;
            PG8_LDB(B1, 1, 1); PG8_STAGE(PG8_SB(1, 0), b3, voffB);
            PG8_BAR; PG8_WAIT_L(0); PG8_MMA(0, 1, At, B1); PG8_BAR;
            PG8_LDA(At, 1, 1); PG8_STAGE(PG8_SA(1, 0), a3, voffA);
            PG8_BAR; PG8_WAIT_L(0); PG8_MMA(1, 0, At, B0); PG8_BAR; PG8_SCHED;
            PG8_STAGE(PG8_SB(1, 1), b3 + hstep, voffB);
            PG8_WAIT_V(6); PG8_BAR; PG8_MMA(1, 1, At, B1); PG8_BAR;
        }
        epilogue(p, kind, l, ch, cur, acc, wr, wc, fr, fq);
        if (!has_next) break;
        if (kind != K_MERGE || cur.aux == 2)
#pragma unroll
        for (int a = 0; a < 2; ++a)
#pragma unroll
            for (int b = 0; b < 2; ++b)
#pragma unroll
                for (int m = 0; m < 4; ++m)
#pragma unroll
                    for (int n = 0; n < 2; ++n) acc[a][b][m][n] = (f32x4){0.f, 0.f, 0.f, 0.f};
        cur = nxt; cA = nA; cB = nB; ++ui;
    }
    PG8_WAIT_V(0);
    if (wr == 0) PG8_BAR;
    PG8_BAR;
#undef PG8_SA
#undef PG8_SB
#undef PG8_STAGE
#undef PG8_LDA
#undef PG8_LDB
#undef PG8_MMA
#undef PG8_WAIT_V
#undef PG8_WAIT_L
#undef PG8_BAR
#undef PG8_SCHED
}

constexpr int N_PHASES = 1 + DEPTH * NCH * 5 + 1;

__global__ void __launch_bounds__(NTHREADS, 2) fwd_megakernel(Params p) {
    extern __shared__ __attribute__((aligned(16))) unsigned char lds_raw[];
    LAS unsigned char* lds = (LAS unsigned char*)lds_raw;
    cg::grid_group grid = cg::this_grid();
    const int wv0 = __builtin_amdgcn_readfirstlane(threadIdx.x >> 6);
    for (int ph = p.ph_lo; ph < p.ph_hi; ++ph) {
        int wvq = wv0; asm volatile("" : "+s"(wvq));
        int lnq; asm volatile("v_mbcnt_lo_u32_b32 %0, -1, 0\n\tv_mbcnt_hi_u32_b32 %0, -1, %0" : "=v"(lnq));
        int tid = (wvq << 6) | lnq, bid = blockIdx.x;
#define LAUNDER() do { asm volatile("" : "+v"(tid)); asm volatile("" : "+s"(bid)); } while (0)
        LAUNDER();
        if (ph == 0) {
            for (int rep = 0; rep < 1 + REP_P0; ++rep) { LAUNDER(); p0_prologue(p, lds, tid, bid); }
        } else if (ph == N_PHASES - 1) {
            pf_final(p, tid, bid);
        } else {
            const int q = ph - 1, s = q % 5, lc = q / 5, ch = lc % NCH, l = lc / NCH;
            if (s == 0) p1_norm(p, l, ch, tid, bid);
            else if (s == 1) { for (int rep = 0; rep < 1 + REP_P2; ++rep) { LAUNDER(); gemm_phase(p, lds, K_IN, l, ch, 1024, tid, bid); } }
            else if (s == 2) {
                for (int rep = REP_DFT; rep >= 0; --rep) { LAUNDER();
                    gemm_phase(p, lds, K_DFT, l, ch | (rep ? 0x100 : 0), 8192, tid, bid);
                    if (l < DEPTH - 1) gemm_phase(p, lds, K_CDFT, l, ch | (rep ? 0x100 : 0), 512, tid, bid);
                }
                p3_conv(p, l, tid, bid);
                for (int rep = REP_ATT; rep >= 0; --rep) { LAUNDER(); p3_attn(p, l, (LAS float*)(lds + LDS_STAGE), tid, bid, rep != 0); }
            }
            else if (s == 3) { for (int rep = 0; rep < 1 + REP_P4; ++rep) { LAUNDER(); gemm_phase(p, lds, K_MERGE, l, ch, 512, tid, bid); } }
            else gemm_phase(p, lds, K_OUT, l, ch, 1024, tid, bid);
        }
        if (ph + 1 < p.ph_hi) grid.sync();
    }
}

extern "C" void kernel_launch(void* const* d_in, const int* in_sizes, int n_in, void* d_out, int out_size, void* d_ws, size_t ws_size, hipStream_t stream) {
    static int grid_blocks = 0;
    if (!grid_blocks) {
        int dev = 0, cus = 0, per_cu = 0;
        hipGetDevice(&dev);
        hipDeviceGetAttribute(&cus, hipDeviceAttributeMultiprocessorCount, dev);
        if (hipFuncSetAttribute((const void*)fwd_megakernel, hipFuncAttributeMaxDynamicSharedMemorySize, LDS_BYTES) != hipSuccess) fprintf(stderr, "kernel_launch: hipFuncSetAttribute failed\n");
        hipOccupancyMaxActiveBlocksPerMultiprocessor(&per_cu, (const void*)fwd_megakernel, NTHREADS, LDS_BYTES);
        if (per_cu < 1) { fprintf(stderr, "kernel_launch: occupancy query says %d blocks/CU\n", per_cu); per_cu = 1; }
        (void)hipGetLastError();
        grid_blocks = cus * per_cu;
        if (ws_size < WS_END) fprintf(stderr, "kernel_launch: workspace too small: %zu < %zu\n", ws_size, (size_t)WS_END);
    }
    Params p{};
    const float** f = (const float**)&p;
    for (int i = 0; i < 17; ++i) f[i] = (const float*)d_in[i];
    p.out = (float*)d_out; p.ws = (unsigned char*)d_ws;
#if MULTI_LAUNCH
    for (int ph = 0; ph < N_PHASES; ++ph) {
        p.ph_lo = ph; p.ph_hi = ph + 1;
        hipLaunchKernelGGL(fwd_megakernel, dim3(grid_blocks), dim3(NTHREADS), LDS_BYTES, stream, p);
    }
#else
    p.ph_lo = 0; p.ph_hi = N_PHASES;
    void* args[] = {&p};
    hipError_t e = hipLaunchCooperativeKernel((const void*)fwd_megakernel, dim3(grid_blocks), dim3(NTHREADS), args, LDS_BYTES, stream);
    if (e != hipSuccess) fprintf(stderr, "cooperative launch failed: %s (grid %d)\n", hipGetErrorString(e), grid_blocks);
#endif
}
```

```cpp
#include <hip/hip_runtime.h>
#include <hip/hip_cooperative_groups.h>
#include <cstdio>
namespace cg = cooperative_groups;

#define LAS __attribute__((address_space(3)))
typedef _Float16 h16;
typedef _Float16 h8 __attribute__((ext_vector_type(8)));
typedef _Float16 h4 __attribute__((ext_vector_type(4)));
typedef float f32x4 __attribute__((ext_vector_type(4)));

#ifndef MULTI_LAUNCH
#define MULTI_LAUNCH 0
#endif
#define REP_P0 0
#define REP_P2 0
#define REP_P4 0

constexpr int DM = 1024, NBATCH = 16, SEQ = 4096, DEPTH = 4, CTXL = 256, DIN = 8192;
constexpr int BC = 8, NCH = 2;
constexpr int TL = BC * SEQ, TX = BC * CTXL, TC = TL + TX;
constexpr int NIN = 8704;
constexpr int NTHREADS = 512;
constexpr int LDS_STAGE = 131072, LDS_BYTES = LDS_STAGE + 16384;

constexpr size_t al256(size_t x) { return (x + 255) & ~(size_t)255; }
constexpr size_t OFF_WIN = 0;
constexpr size_t OFF_BIN = al256(OFF_WIN + (size_t)DEPTH * NIN * 1024 * 2);
constexpr size_t OFF_WBR = al256(OFF_BIN + (size_t)DEPTH * NIN * 4);
constexpr size_t OFF_WOUT = al256(OFF_WBR + (size_t)DEPTH * 3 * 1024 * 512 * 2);
constexpr size_t OFF_CS = al256(OFF_WOUT + (size_t)DEPTH * 1024 * 1024 * 2);
constexpr size_t OFF_CS2 = al256(OFF_CS + (size_t)16 * 256 * 2 * 4);
constexpr size_t OFF_MOD = al256(OFF_CS2 + (size_t)256 * 512 * 2);
constexpr size_t OFF_CTXR = al256(OFF_MOD + (size_t)DEPTH * 17 * 3072 * 4);
constexpr size_t OFF_H = al256(OFF_CTXR + (size_t)NBATCH * CTXL * 1024 * 4);
constexpr size_t OFF_M = al256(OFF_H + (size_t)TC * 1024 * 2);
constexpr size_t SZ512 = (size_t)TC * 512 * 2;
constexpr size_t OFF_CX = al256(OFF_M + (size_t)TC * 1024 * 2);
constexpr size_t OFF_BZ = al256(OFF_CX + SZ512);
constexpr size_t OFF_FZ = al256(OFF_BZ + SZ512);
constexpr size_t OFF_Q = al256(OFF_FZ + SZ512);
constexpr size_t OFF_K = al256(OFF_Q + SZ512);
constexpr size_t OFF_CZ = al256(OFF_K + SZ512);
constexpr size_t OFF_AACT = al256(OFF_CZ + SZ512);
constexpr size_t OFF_G = al256(OFF_AACT + SZ512);
constexpr size_t OFF_VTL = al256(OFF_G + (size_t)TC * 3072 * 2);
constexpr size_t OFF_VTC = al256(OFF_VTL + (size_t)BC * 512 * 8192 * 2);
constexpr size_t OFF_VF = al256(OFF_VTC + (size_t)BC * 512 * 512 * 2);
constexpr size_t WS_END = al256(OFF_VF + SZ512);

struct Params {
    const float *x, *c, *ctx, *c_ctx, *norm_g, *w_ada, *b_ada, *w_in, *b_in, *w_conv, *b_conv, *rpb, *w_br_a, *w_br_f, *w_br_c, *w_out, *final_g;
    float* out; unsigned char* ws; int ph_lo, ph_hi;
};

__device__ __forceinline__ float shx(float v, int m, int lane) { return __int_as_float(__builtin_amdgcn_ds_bpermute((lane ^ m) << 2, __float_as_int(v))); }
__device__ __forceinline__ float silu_f(float v) { return v * __builtin_amdgcn_rcpf(1.f + __expf(-v)); }
__device__ __forceinline__ float sigm_f(float v) { return __builtin_amdgcn_rcpf(1.f + __expf(-v)); }

__device__ __forceinline__ int in_col(int n) {
    const int j = n >> 8, w = n & 255;
    if (j < 4) return (w < 128) ? (128 * j + w) : (1024 + 128 * j + (w - 128));
    if (j < 8) return (w < 128) ? (512 + 128 * (j - 4) + w) : (1536 + 128 * (j - 4) + (w - 128));
    if (j < 10) return 2560 + (j - 8) * 256 + w;
    if (j < 12) return 3072 + (j - 10) * 256 + w;
    if (j < 14) return 3584 + (j - 12) * 256 + w;
    if (j < 16) return 4608 + (j - 14) * 256 + w;
    if (j < 28) return 5120 + (j - 16) * 256 + w;
    return 4096 + (n - 7168);
}

template <bool PERMCOL>
__device__ __forceinline__ void transpose_tile(const int tid, const float* __restrict__ src, int lds_, h16* __restrict__ dst, int ldd, int k0, int n0, LAS float* t) {
    const int a = tid & 63, b = tid >> 6;
    const int col = PERMCOL ? in_col(n0 + a) : (n0 + a);
#pragma unroll
    for (int it = 0; it < 8; ++it) { const int k = b + it * 8; t[k * 65 + a] = src[(size_t)(k0 + k) * lds_ + col]; }
    __syncthreads();
#pragma unroll
    for (int it = 0; it < 8; ++it) { const int n = b + it * 8; dst[(size_t)(n0 + n) * ldd + k0 + a] = (h16)t[a * 65 + n]; }
    __syncthreads();
}

__device__ __forceinline__ void p0_prologue(const Params& p, LAS unsigned char* lds, const int tid, const int bid) {
    const int G = gridDim.x;
    unsigned char* ws = p.ws;
    LAS float* lf = (LAS float*)lds;
    constexpr int N_MOD = DEPTH * 24;
    constexpr int N_TIN = DEPTH * 120 * 16;
    constexpr int N_FOU = DEPTH * 1024;
    constexpr int N_BIAS = DEPTH;
    constexpr int N_TBR = DEPTH * 3 * 16 * 8;
    constexpr int N_TOUT = DEPTH * 16 * 16;
    constexpr int N_CS = 8;
    constexpr int N_CS2 = 32;
    constexpr int E0 = N_MOD, E1 = E0 + N_TIN, E2 = E1 + N_FOU, E3 = E2 + N_BIAS, E4 = E3 + N_TBR, E5 = E4 + N_TOUT, E6 = E5 + N_CS, E7 = E6 + N_CS2;
    for (int it = bid; it < E7; it += G) {
        if (it < E0) {
            const int l = it / 24, cb = it % 24;
            for (int i = tid; i < 17 * 1024; i += NTHREADS) { const float v = (i < 16 * 1024) ? p.c[i] : p.c_ctx[i - 16 * 1024]; lf[i] = silu_f(v); }
            __syncthreads();
            const int col = cb * 128 + (tid & 127), kq = tid >> 7;
            float acc[17];
#pragma unroll
            for (int j = 0; j < 17; ++j) acc[j] = 0.f;
            const float* wp = p.w_ada + (size_t)l * 1024 * 3072 + col;
            for (int k = kq * 256; k < kq * 256 + 256; ++k) {
                const float w = wp[(size_t)k * 3072];
#pragma unroll
                for (int j = 0; j < 17; ++j) acc[j] += lf[j * 1024 + k] * w;
            }
            LAS float* red = lf + 17 * 1024;
#pragma unroll
            for (int j = 0; j < 17; ++j) red[(kq * 17 + j) * 128 + (tid & 127)] = acc[j];
            __syncthreads();
            float* MOD = (float*)(ws + OFF_MOD);
            for (int i = tid; i < 17 * 128; i += NTHREADS) {
                const int j = i >> 7, cc = i & 127;
                const float s = red[(0 * 17 + j) * 128 + cc] + red[(1 * 17 + j) * 128 + cc] + red[(2 * 17 + j) * 128 + cc] + red[(3 * 17 + j) * 128 + cc];
                MOD[((size_t)l * 17 + j) * 3072 + cb * 128 + cc] = s + p.b_ada[l * 3072 + cb * 128 + cc];
            }
            __syncthreads();
        } else if (it < E1) {
            const int t = it - E0, l = t / (120 * 16), r = t % (120 * 16), nt = r / 16, kt = r % 16;
            transpose_tile<true>(tid, p.w_in + (size_t)l * 1024 * DIN, DIN, (h16*)(ws + OFF_WIN) + (size_t)l * NIN * 1024, 1024, kt * 64, nt * 64, lf);
        } else if (it < E2) {
            const int t = it - E1, l = t >> 10, k = t & 1023;
            lf[tid] = p.w_in[((size_t)l * 1024 + k) * DIN + 2048 + tid];
            if (tid < 128) { lf[512 + tid] = cospif((float)tid * (1.f / 64.f)); lf[640 + tid] = sinpif((float)tid * (1.f / 64.f)); }
            __syncthreads();
            const int g = tid >> 7, kk = tid & 127;
            float re = 0.f, im = 0.f;
            for (int n2 = 0; n2 < 128; ++n2) { const float w = lf[g * 128 + n2]; const int ix = (n2 * kk) & 127; re += w * lf[512 + ix]; im -= w * lf[640 + ix]; }
            h16* W = (h16*)(ws + OFF_WIN) + (size_t)l * NIN * 1024;
            W[(size_t)(7680 + tid) * 1024 + k] = (h16)(re * 0.08838834764831845f);
            W[(size_t)(7680 + 512 + tid) * 1024 + k] = (h16)(im * 0.08838834764831845f);
            __syncthreads();
        } else if (it < E3) {
            const int l = it - E2;
            float* B = (float*)(ws + OFF_BIN) + (size_t)l * NIN;
            const float* bi = p.b_in + (size_t)l * DIN;
            for (int n = tid; n < 7680; n += NTHREADS) B[n] = bi[in_col(n)];
            const int g = tid >> 7, kk = tid & 127;
            float re = 0.f, im = 0.f;
            for (int n2 = 0; n2 < 128; ++n2) { const float w = bi[2048 + g * 128 + n2]; const float ang = (float)((n2 * kk) & 127) * (1.f / 64.f); re += w * cospif(ang); im -= w * sinpif(ang); }
            B[7680 + tid] = re * 0.08838834764831845f; B[7680 + 512 + tid] = im * 0.08838834764831845f;
        } else if (it < E4) {
            const int t = it - E3, lb = t / 128, r = t % 128, nt = r / 8, kt = r % 8, l = lb / 3, br = lb % 3;
            const float* src = (br == 0 ? p.w_br_a : (br == 1 ? p.w_br_f : p.w_br_c)) + (size_t)l * 512 * 1024;
            transpose_tile<false>(tid, src, 1024, (h16*)(ws + OFF_WBR) + (size_t)lb * 1024 * 512, 512, kt * 64, nt * 64, lf);
        } else if (it < E5) {
            const int t = it - E4, l = t / 256, r = t % 256, nt = r / 16, kt = r % 16;
            transpose_tile<false>(tid, p.w_out + (size_t)l * 1024 * 1024, 1024, (h16*)(ws + OFF_WOUT) + (size_t)l * 1024 * 1024, 1024, kt * 64, nt * 64, lf);
        } else if (it < E6) {
            const int e = (it - E5) * NTHREADS + tid, k1 = e >> 8, n2 = e & 255;
            const float ang = (float)(k1 * n2) * (1.f / 2048.f);
            float* TW = (float*)(ws + OFF_CS);
            TW[2 * e] = cospif(ang); TW[2 * e + 1] = sinpif(ang);
        } else {
            const size_t e0 = ((size_t)(it - E6) * NTHREADS + tid) * 8;
            const int k1 = (int)(e0 >> 9), j0 = (int)(e0 & 511);
            h8 o;
#pragma unroll
            for (int j = 0; j < 8; ++j) { const int jj = j0 + j, pos = jj & 255; const float ang = (float)((k1 * pos) & 255) * (1.f / 128.f); o[j] = (h16)((jj < 256) ? cospif(ang) : sinpif(ang)); }
            *(h8*)((h16*)(ws + OFF_CS2) + e0) = o;
        }
    }
}

__device__ __forceinline__ void p1_norm(const Params& p, int l, int ch, const int tid, const int bid) {
    const int lane = tid & 63, wid = tid >> 6;
    unsigned char* ws = p.ws;
    const float* xsrc = (l == 0) ? p.x : p.out;
    const float* csrc = (l == 0) ? p.ctx : (const float*)(ws + OFF_CTXR);
    const float* MOD = (const float*)(ws + OFF_MOD) + (size_t)l * 17 * 3072;
    const float* ng = p.norm_g + l * 1024;
    h16* H = (h16*)(ws + OFF_H);
    for (int row = bid * 8 + wid; row < TC; row += gridDim.x * 8) {
        const float* src = (row < TL) ? xsrc + ((size_t)ch * TL + row) * 1024 : csrc + ((size_t)ch * TX + (row - TL)) * 1024;
        const float* mod = MOD + (size_t)((row < TL) ? (ch * BC + (row >> 12)) : 16) * 3072;
        f32x4 v[4]; float ss = 0.f;
#pragma unroll
        for (int it = 0; it < 4; ++it) { v[it] = *(const f32x4*)(src + it * 256 + lane * 4); ss += v[it][0] * v[it][0] + v[it][1] * v[it][1] + v[it][2] * v[it][2] + v[it][3] * v[it][3]; }
#pragma unroll
        for (int o = 32; o >= 1; o >>= 1) ss += shx(ss, o, lane);
        const float inv = rsqrtf(ss * (1.f / 1024.f) + 1e-6f);
#pragma unroll
        for (int it = 0; it < 4; ++it) {
            const int c = it * 256 + lane * 4;
            const f32x4 g = *(const f32x4*)(ng + c), sh = *(const f32x4*)(mod + c), sc = *(const f32x4*)(mod + 1024 + c);
            h4 o;
#pragma unroll
            for (int j = 0; j < 4; ++j) o[j] = (h16)(v[it][j] * inv * g[j] * (1.f + sc[j]) + sh[j]);
            *(h4*)(H + (size_t)row * 1024 + c) = o;
        }
    }
}

__device__ __forceinline__ void pf_final(const Params& p, const int tid, const int bid) {
    const int lane = tid & 63, wid = tid >> 6;
    for (int row = bid * 8 + wid; row < NBATCH * SEQ; row += gridDim.x * 8) {
        float* src = p.out + (size_t)row * 1024;
        f32x4 v[4]; float ss = 0.f;
#pragma unroll
        for (int it = 0; it < 4; ++it) { v[it] = *(const f32x4*)(src + it * 256 + lane * 4); ss += v[it][0] * v[it][0] + v[it][1] * v[it][1] + v[it][2] * v[it][2] + v[it][3] * v[it][3]; }
#pragma unroll
        for (int o = 32; o >= 1; o >>= 1) ss += shx(ss, o, lane);
        const float inv = rsqrtf(ss * (1.f / 1024.f) + 1e-6f);
#pragma unroll
        for (int it = 0; it < 4; ++it) { const int c = it * 256 + lane * 4; const f32x4 g = *(const f32x4*)(p.final_g + c); *(f32x4*)(src + c) = v[it] * inv * g; }
    }
}

__device__ __forceinline__ void p3_conv(const Params& p, int l, const int tid, const int bid) {
    unsigned char* ws = p.ws;
    const h16* CX = (const h16*)(ws + OFF_CX); const h16* BZ = (const h16*)(ws + OFF_BZ); h16* AA = (h16*)(ws + OFF_AACT);
    const float* wc = p.w_conv + (size_t)l * 3 * 512; const float* bc = p.b_conv + (size_t)l * 512;
    const int nrows = (l == DEPTH - 1) ? TL : TC;
    for (int idx = bid * NTHREADS + tid; idx < nrows * 64; idx += gridDim.x * NTHREADS) {
        const int row = idx >> 6, c8 = (idx & 63) * 8;
        const int pos = (row < TL) ? (row & 4095) : ((row - TL) & 255), L = (row < TL) ? 4096 : 256;
        const h8 z = {0, 0, 0, 0, 0, 0, 0, 0};
        const h8 cur = *(const h8*)(CX + (size_t)row * 512 + c8);
        const h8 prv = (pos > 0) ? *(const h8*)(CX + (size_t)(row - 1) * 512 + c8) : z;
        const h8 nxt = (pos < L - 1) ? *(const h8*)(CX + (size_t)(row + 1) * 512 + c8) : z;
        const h8 bz = *(const h8*)(BZ + (size_t)row * 512 + c8);
        h8 o;
#pragma unroll
        for (int j = 0; j < 8; ++j) {
            const float cv = wc[c8 + j] * (float)prv[j] + wc[512 + c8 + j] * (float)cur[j] + wc[1024 + c8 + j] * (float)nxt[j] + bc[c8 + j];
            o[j] = (h16)((float)bz[j] * cv);
        }
        *(h8*)(AA + (size_t)row * 512 + c8) = o;
    }
}

__device__ __forceinline__ const h16* katt(const h16* Kb, int keytok, int h, int fq) { return Kb + ((size_t)((keytok >> 3) * 8 + h) * 8 + fq) * 64 + (keytok & 7) * 8; }
__device__ __forceinline__ const h16* vatt(const h16* VF, int tk, int h, int dt, int fr) { return VF + ((size_t)((tk >> 3) * 8 + h) * 4 + dt) * 128 + (((tk >> 2) & 1) * 16 + fr) * 4; }

template <bool LAT>
__device__ __forceinline__ void attn_unit(const h16* Qb, const h16* Kb, const h16* VF, h16* CZ, const LAS float* rpbL, const int bb, const int h, const int r, const int n, const int tokQ0, const int fr, const int fq, const int lane, const bool dummy) {
    constexpr int NT = LAT ? 32 : 16, NKB = NT / 4, NP = NT / 2, NVB = NP / 4;
    const f32x4 zero4 = {0.f, 0.f, 0.f, 0.f};
    const int tokQ = tokQ0 + fr;
    const h16* qp = Qb + (size_t)tokQ * 512 + h * 64 + fq * 8;
    const h8 q0 = *(const h8*)qp, q1 = *(const h8*)(qp + 32);
    int kcs = n * 16 - 8; kcs = kcs < 0 ? 0 : (kcs > 32 ? 32 : kcs);
    int rs = r - 4; rs = rs < 0 ? 0 : (rs > 56 ? 56 : rs);
    const int qcol = n * 16 + fr; int cs = qcol - 8; cs = cs < 0 ? 0 : (cs > 48 ? 48 : cs);
#define ATT_TOK(t) ((LAT && (t) < 16) ? (bb * 4096 + (rs + ((t) >> 1)) * 64 + kcs + 16 * ((t) & 1)) : (TL + bb * 256 + ((t) - (LAT ? 16 : 0)) * 16))
    f32x4 s[NT];
    h8 kb[2][4][2];
#pragma unroll
    for (int tt = 0; tt < 4; ++tt) { const h16* kp = katt(Kb, ATT_TOK(tt) + fr, h, fq); kb[0][tt][0] = *(const h8*)kp; kb[0][tt][1] = *(const h8*)(kp + 256); }
#pragma unroll
    for (int b = 0; b < NKB; ++b) {
        if (b + 1 < NKB) {
#pragma unroll
            for (int tt = 0; tt < 4; ++tt) { const int t = (b + 1) * 4 + tt; const h16* kp = katt(Kb, ATT_TOK(t) + fr, h, fq); kb[(b + 1) & 1][tt][0] = *(const h8*)kp; kb[(b + 1) & 1][tt][1] = *(const h8*)(kp + 256); }
        }
        __builtin_amdgcn_sched_barrier(0);
#pragma unroll
        for (int tt = 0; tt < 4; ++tt) {
            const int t = b * 4 + tt;
            f32x4 a = zero4;
            a = __builtin_amdgcn_mfma_f32_16x16x32_f16(kb[b & 1][tt][0], q0, a, 0, 0, 0);
            a = __builtin_amdgcn_mfma_f32_16x16x32_f16(kb[b & 1][tt][1], q1, a, 0, 0, 0);
            if (LAT && t < 16) {
                const int i = t >> 1, par = t & 1;
                const int kc0 = kcs + 16 * par + 4 * fq;
                const LAS float* bp = rpbL + (h * 15 + (rs + i - r + 7)) * 31;
#pragma unroll
                for (int j = 0; j < 4; ++j) {
                    const int kcol = kc0 + j; const bool ok = (kcol >= cs) && (kcol < cs + 16);
                    int dc = kcol - qcol + 15; dc = dc < 0 ? 0 : (dc > 30 ? 30 : dc);
                    a[j] = ok ? a[j] + bp[dc] : -1e30f;
                }
            }
            s[t] = a;
        }
        __builtin_amdgcn_sched_barrier(0);
    }
    h4 vb[2][4][4][2];
#pragma unroll
    for (int pp = 0; pp < 4; ++pp)
#pragma unroll
        for (int dt = 0; dt < 4; ++dt) { const int tk = ATT_TOK(2 * pp) + 4 * fq; vb[0][pp][dt][0] = *(const h4*)vatt(VF, tk, h, dt, fr); vb[0][pp][dt][1] = *(const h4*)vatt(VF, tk + 16, h, dt, fr); }
    __builtin_amdgcn_sched_barrier(0);
    float mx = -3e38f;
#pragma unroll
    for (int t = 0; t < NT; ++t) mx = fmaxf(mx, fmaxf(fmaxf(s[t][0], s[t][1]), fmaxf(s[t][2], s[t][3])));
    mx = fmaxf(mx, shx(mx, 16, lane)); mx = fmaxf(mx, shx(mx, 32, lane));
    float sum = 0.f;
    h8 pf[NP];
#pragma unroll
    for (int tp = 0; tp < NP; ++tp) {
#pragma unroll
        for (int j = 0; j < 4; ++j) {
            const float e0 = __expf(s[2 * tp][j] - mx), e1 = __expf(s[2 * tp + 1][j] - mx);
            sum += e0 + e1; pf[tp][j] = (h16)e0; pf[tp][4 + j] = (h16)e1;
        }
    }
    sum += shx(sum, 16, lane); sum += shx(sum, 32, lane);
    f32x4 o[4] = {zero4, zero4, zero4, zero4};
#pragma unroll
    for (int b = 0; b < NVB; ++b) {
        if (b + 1 < NVB) {
#pragma unroll
            for (int pp = 0; pp < 4; ++pp)
#pragma unroll
                for (int dt = 0; dt < 4; ++dt) { const int tk = ATT_TOK(2 * ((b + 1) * 4 + pp)) + 4 * fq; vb[(b + 1) & 1][pp][dt][0] = *(const h4*)vatt(VF, tk, h, dt, fr); vb[(b + 1) & 1][pp][dt][1] = *(const h4*)vatt(VF, tk + 16, h, dt, fr); }
        }
        __builtin_amdgcn_sched_barrier(0);
#pragma unroll
        for (int pp = 0; pp < 4; ++pp)
#pragma unroll
            for (int dt = 0; dt < 4; ++dt) {
                const h4 v0 = vb[b & 1][pp][dt][0], v1 = vb[b & 1][pp][dt][1];
                const h8 vf = {v0[0], v0[1], v0[2], v0[3], v1[0], v1[1], v1[2], v1[3]};
                o[dt] = __builtin_amdgcn_mfma_f32_16x16x32_f16(vf, pf[b * 4 + pp], o[dt], 0, 0, 0);
            }
        __builtin_amdgcn_sched_barrier(0);
    }
#undef ATT_TOK
    const float inv = 1.f / sum;
#pragma unroll
    for (int dt = 0; dt < 4; ++dt) {
        h16* cp = CZ + (size_t)tokQ * 512 + h * 64 + 16 * dt + 4 * fq;
        const h4 cz = *(const h4*)cp; h4 ov;
#pragma unroll
        for (int j = 0; j < 4; ++j) ov[j] = (h16)(o[dt][j] * inv * (float)cz[j]);
        *(h4*)cp = ov;
    }
}

__device__ __forceinline__ void p3_attn(const Params& p, int l, LAS float* rpbL, const int tid, const int bid, const bool dummy) {
    const int lane = tid & 63, wid = tid >> 6, fr = lane & 15, fq = lane >> 4;
    unsigned char* ws = p.ws;
    const h16* Qb = (const h16*)(ws + OFF_Q); const h16* Kb = (const h16*)(ws + OFF_K);
    const h16* VF = (const h16*)(ws + OFF_VF);
    h16* CZ = (h16*)(ws + OFF_CZ);
    for (int i = tid; i < 8 * 15 * 31; i += NTHREADS) rpbL[i] = p.rpb[(size_t)l * 8 * 15 * 31 + i];
    __syncthreads();
    for (int u = bid * 8 + wid; u < BC * 8 * 64 * 4; u += gridDim.x * 8) {
        const int n = u & 3, r = (u >> 2) & 63, h = (u >> 8) & 7, bb = u >> 11;
        attn_unit<true>(Qb, Kb, VF, CZ, rpbL, bb, h, r, n, bb * 4096 + r * 64 + n * 16, fr, fq, lane, dummy);
    }
    if (l < DEPTH - 1) {
        for (int u = bid * 8 + wid; u < BC * 8 * 16; u += gridDim.x * 8) {
            const int qg = u & 15, h = (u >> 4) & 7, bb = u >> 7;
            attn_unit<false>(Qb, Kb, VF, CZ, rpbL, bb, h, 0, 0, TL + bb * 256 + qg * 16, fr, fq, lane, dummy);
        }
    }
}

__device__ __forceinline__ void dft4(f32x4& r0, f32x4& i0, f32x4& r1, f32x4& i1, f32x4& r2, f32x4& i2, f32x4& r3, f32x4& i3) {
    const f32x4 t0r = r0 + r2, t0i = i0 + i2, t1r = r0 - r2, t1i = i0 - i2, t2r = r1 + r3, t2i = i1 + i3, t3r = r1 - r3, t3i = i1 - i3;
    r0 = t0r + t2r; i0 = t0i + t2i; r2 = t0r - t2r; i2 = t0i - t2i;
    r1 = t1r + t3i; i1 = t1i - t3r; r3 = t1r - t3i; i3 = t1i + t3r;
}
__device__ __forceinline__ void cmulc(f32x4& r, f32x4& i, const float wr, const float wi) { const f32x4 a = r * wr - i * wi, b = r * wi + i * wr; r = a; i = b; }
__device__ __forceinline__ void p3_dft1(const Params& p, const int tid, const int bid) {
    unsigned char* ws = p.ws;
    const h16* VT = (const h16*)(ws + OFF_VTL); h16* TP = (h16*)(ws + OFF_H); const float* TW = (const float*)(ws + OFF_CS);
    constexpr float C1 = 0.92387953251f, S1 = 0.38268343237f, C2 = 0.70710678119f;
    for (int idx = bid * NTHREADS + tid; idx < BC * 512 * 64; idx += gridDim.x * NTHREADS) {
        const int q4 = idx & 63, c = (idx >> 6) & 511, bb = idx >> 15, n2 = 4 * q4;
        const h16* src = VT + (size_t)(bb * 512 + c) * 8192 + n2;
        f32x4 xr[16], xi[16];
#pragma unroll
        for (int n1 = 0; n1 < 16; ++n1) {
            const h4 a = *(const h4*)(src + 256 * n1), b = *(const h4*)(src + 4096 + 256 * n1);
#pragma unroll
            for (int j = 0; j < 4; ++j) { xr[n1][j] = (float)a[j]; xi[n1][j] = (float)b[j]; }
        }
#pragma unroll
        for (int b = 0; b < 4; ++b) dft4(xr[b], xi[b], xr[4 + b], xi[4 + b], xr[8 + b], xi[8 + b], xr[12 + b], xi[12 + b]);
        cmulc(xr[5], xi[5], C1, -S1);
        cmulc(xr[6], xi[6], C2, -C2);
        cmulc(xr[7], xi[7], S1, -C1);
        cmulc(xr[9], xi[9], C2, -C2);
        cmulc(xr[10], xi[10], 0.f, -1.f);
        cmulc(xr[11], xi[11], -C2, -C2);
        cmulc(xr[13], xi[13], S1, -C1);
        cmulc(xr[14], xi[14], -C2, -C2);
        cmulc(xr[15], xi[15], -C1, S1);
#pragma unroll
        for (int cc = 0; cc < 4; ++cc) dft4(xr[4 * cc], xi[4 * cc], xr[4 * cc + 1], xi[4 * cc + 1], xr[4 * cc + 2], xi[4 * cc + 2], xr[4 * cc + 3], xi[4 * cc + 3]);
#pragma unroll
        for (int k1 = 0; k1 < 16; ++k1) {
            const int ix = 4 * (k1 & 3) + (k1 >> 2);
            const f32x4 t0 = *(const f32x4*)(TW + 2 * (k1 * 256 + n2)), t1 = *(const f32x4*)(TW + 2 * (k1 * 256 + n2) + 4);
            const f32x4 tr = {t0[0], t0[2], t1[0], t1[2]}, ti = {t0[1], t0[3], t1[1], t1[3]};
            const f32x4 rr = xr[ix] * tr + xi[ix] * ti, ii = xi[ix] * tr - xr[ix] * ti;
            h4 orr, oii;
#pragma unroll
            for (int j = 0; j < 4; ++j) { orr[j] = (h16)rr[j]; oii[j] = (h16)ii[j]; }
            h16* dst = TP + ((size_t)((bb * 16 + k1) * 512 + c)) * 512 + n2;
            *(h4*)dst = orr; *(h4*)(dst + 256) = oii;
        }
    }
}

constexpr int BM = 256, BK = 64, HALF = 128, HTB = HALF * BK * 2;
enum { K_IN = 0, K_DFT = 1, K_CDFT = 2, K_MERGE = 3, K_OUT = 4 };
struct Unit { const char* A; const char* B; int pm, pn, aux; };

__device__ __forceinline__ int lds_byte(int r, int c) { const int st = (r >> 4) * 2 + (c >> 5), rr = r & 15, cc = c & 31, ob = rr * 64 + cc * 2; return st * 1024 + (ob ^ (((ob >> 9) & 1) << 5)); }
__device__ __forceinline__ void stage_rc(int b, int& R, int& C) { const int st = b / 1024, sb = b % 1024, swz = sb ^ (((sb >> 9) & 1) << 5); R = (st >> 1) * 16 + swz / 64; C = (st & 1) * 32 + (swz % 64) / 2; }
__device__ __forceinline__ int perm32(int rho) { const int n = rho >> 4, i = rho & 15; return 8 * (i >> 2) + 4 * n + (i & 3); }

__device__ __forceinline__ bool sched_next(const Params& p, const int kind, const int l, const int i, Unit& u, const int bid) {
    const int G = gridDim.x, c = bid;
    const char* ws = (const char*)p.ws;
    if (kind == K_IN) {
        constexpr int nM = TC / 256, nN = NIN / 256, nwg = nM * nN;
        const long L = (long)i * G + c; if (L >= nwg) return false;
        int wgid = (int)L; { const int q = nwg / 8, r = nwg % 8, xcd = wgid % 8, off = wgid / 8; wgid = (xcd < r ? xcd * (q + 1) : r * (q + 1) + (xcd - r) * q) + off; }
        const int nig = 8 * nN, gid = wgid / nig, fm = gid * 8, gsz = (nM - fm) < 8 ? (nM - fm) : 8;
        const int pm = fm + ((wgid % nig) % gsz), pn = (wgid % nig) / gsz;
        const char* Hp = ws + OFF_H + (size_t)pm * 256 * 1024 * 2;
        const char* Wp = ws + OFF_WIN + ((size_t)l * NIN + pn * 256) * 1024 * 2;
        if (pn < 28) { u.A = Hp; u.B = Wp; } else { u.A = Wp; u.B = Hp; }
        u.pm = pm; u.pn = pn; u.aux = 0; return true;
    } else if (kind == K_DFT) {
        const int L = i * G + c; if (L >= BC * 32) return false;
        const int bb = L & 7, pn = L >> 3;
        u.A = ws + OFF_CS2; u.B = ws + OFF_H + ((size_t)bb * 8192 + pn * 256) * 512 * 2;
        u.pm = 0; u.pn = pn; u.aux = bb; return true;
    } else if (kind == K_CDFT) {
        const int L = i * G + c; if (L >= BC * 2) return false;
        const int bb = L >> 1, pn = L & 1;
        u.A = ws + OFF_CS2; u.B = ws + OFF_VTC + ((size_t)(bb * 512 + pn * 256)) * 512 * 2;
        u.pm = 0; u.pn = pn; u.aux = bb; return true;
    } else if (kind == K_MERGE) {
        const int ntile = ((l == DEPTH - 1) ? TL / 256 : TC / 256) * 4;
        const int ti = (i / 3) * G + c, br = i % 3; if (ti >= ntile) return false;
        const int pm = ti >> 2, pn = ti & 3;
        const size_t aoff = (br == 0) ? OFF_AACT : (br == 1 ? OFF_FZ : OFF_CZ);
        u.A = ws + aoff + (size_t)pm * 256 * 512 * 2; u.B = ws + OFF_WBR + ((size_t)((l * 3 + br) * 1024 + pn * 256)) * 512 * 2;
        u.pm = pm; u.pn = pn; u.aux = br; return true;
    } else {
        const int ntile = ((l == DEPTH - 1) ? TL / 256 : TC / 256) * 4;
        const int ti = i * G + c; if (ti >= ntile) return false;
        const int pm = ti >> 2, pn = ti & 3;
        u.A = ws + OFF_M + (size_t)pm * 256 * 1024 * 2; u.B = ws + OFF_WOUT + ((size_t)(l * 1024 + pn * 256)) * 1024 * 2;
        u.pm = pm; u.pn = pn; u.aux = 0; return true;
    }
}

__device__ __forceinline__ void epilogue(const Params& p, const int kind, const int l, const int ch, const Unit& u, f32x4 (&acc)[2][2][4][2], int wr, int wc, int fr, int fq) {
    unsigned char* ws = p.ws;
    const int cw = wc * 32 + 8 * fq, rl0 = wr * 64 + fr;
    const int pm = u.pm, pn = u.pn;
    if (kind == K_IN) {
        const float* bias = (const float*)(ws + OFF_BIN) + (size_t)l * NIN + pn * 256;
        if (pn < 8) {
            f32x4 b[2][2];
#pragma unroll
            for (int bj = 0; bj < 2; ++bj)
#pragma unroll
                for (int n = 0; n < 2; ++n) b[bj][n] = *(const f32x4*)(bias + 128 * bj + cw + 4 * n);
            h16* dst = (h16*)(ws + (pn < 4 ? OFF_CX : OFF_BZ)) + (size_t)(pm * 256 + rl0) * 512 + 128 * (pn & 3) + cw;
            const bool mul = pn < 4;
#pragma unroll
            for (int ai = 0; ai < 2; ++ai)
#pragma unroll
                for (int m = 0; m < 4; ++m) {
                    h8 o;
#pragma unroll
                    for (int n = 0; n < 2; ++n)
#pragma unroll
                        for (int j = 0; j < 4; ++j) {
                            const float v0 = acc[ai][0][m][n][j] + b[0][n][j], v1 = acc[ai][1][m][n][j] + b[1][n][j];
                            o[4 * n + j] = (h16)(mul ? v0 * v1 : v0 * silu_f(v1));
                        }
                    *(h8*)(dst + (size_t)(128 * ai + 16 * m) * 512) = o;
                }
        } else if (pn < 28) {
            f32x4 b[2][2];
#pragma unroll
            for (int bj = 0; bj < 2; ++bj)
#pragma unroll
                for (int n = 0; n < 2; ++n) b[bj][n] = *(const f32x4*)(bias + 128 * bj + cw + 4 * n);
            size_t off; int ld, oc, act;
            if (pn < 10) { off = OFF_FZ; ld = 512; oc = (pn - 8) * 256; act = 1; }
            else if (pn < 12) { off = OFF_Q; ld = 512; oc = (pn - 10) * 256; act = 3; }
            else if (pn < 14) { off = OFF_K; ld = 512; oc = (pn - 12) * 256; act = 0; }
            else if (pn < 16) { off = OFF_CZ; ld = 512; oc = (pn - 14) * 256; act = 1; }
            else { off = OFF_G; ld = 3072; oc = (pn - 16) * 256; act = 2; }
            h16* dst = (h16*)(ws + off) + (size_t)(pm * 256 + rl0) * ld + oc + cw;
            const bool isk = (pn == 12 || pn == 13);
#pragma unroll
            for (int ai = 0; ai < 2; ++ai)
#pragma unroll
                for (int m = 0; m < 4; ++m)
#pragma unroll
                    for (int bj = 0; bj < 2; ++bj) {
                        h8 o;
#pragma unroll
                        for (int n = 0; n < 2; ++n)
#pragma unroll
                            for (int j = 0; j < 4; ++j) {
                                float v = acc[ai][bj][m][n][j] + b[bj][n][j];
                                if (act == 1) v = silu_f(v); else if (act == 2) v = fmaxf(sigm_f(v), 6.2e-5f); else if (act == 3) v *= 0.125f;
                                o[4 * n + j] = (h16)v;
                            }
                        h16* q = dst + (size_t)(128 * ai + 16 * m) * ld + 128 * bj;
                        if (isk) {
                            const int tok = pm * 256 + 128 * ai + 16 * m + rl0, col = (pn - 12) * 256 + 128 * bj + cw;
                            q = (h16*)(ws + OFF_K) + ((size_t)((tok >> 3) * 8 + (col >> 6)) * 8 + ((col & 63) >> 3)) * 64 + (tok & 7) * 8;
                        }
                        *(h8*)q = o;
                    }
        } else {
            const bool lat = pm < TL / 256;
            const int bb = lat ? (pm >> 4) : (pm - TL / 256), pos0 = lat ? (pm & 15) * 256 : 0;
            if (pn < 30) {
                h16* VF = (h16*)(ws + OFF_VF);
#pragma unroll
                for (int ai = 0; ai < 2; ++ai)
#pragma unroll
                    for (int m = 0; m < 4; ++m) {
                        const int rt = 128 * ai + 16 * m + rl0, chn = (pn - 28) * 256 + rt;
                        const float bv = bias[rt];
#pragma unroll
                        for (int bj = 0; bj < 2; ++bj) {
                            const int t8 = (pm * 256 + 128 * bj + cw) >> 3;
                            h16* q = VF + ((size_t)(t8 * 8 + (chn >> 6)) * 4 + ((chn & 63) >> 4)) * 128 + (chn & 15) * 4;
                            h4 o0, o1;
#pragma unroll
                            for (int j = 0; j < 4; ++j) { o0[j] = (h16)(acc[ai][bj][m][0][j] + bv); o1[j] = (h16)(acc[ai][bj][m][1][j] + bv); }
                            *(h4*)q = o0; *(h4*)(q + 64) = o1;
                        }
                    }
            } else {
                h16* dst; int ld;
                const int part = (pn - 30) >> 1, c0 = ((pn - 30) & 1) * 256;
                if (lat) { dst = (h16*)(ws + OFF_VTL) + ((size_t)(bb * 512 + c0)) * 8192 + part * 4096 + pos0; ld = 8192; }
                else { dst = (h16*)(ws + OFF_VTC) + ((size_t)(bb * 512 + c0)) * 512 + part * 256; ld = 512; }
#pragma unroll
                for (int ai = 0; ai < 2; ++ai)
#pragma unroll
                    for (int m = 0; m < 4; ++m) {
                        const int rt = 128 * ai + 16 * m + rl0;
                        const float bv = bias[rt];
#pragma unroll
                        for (int bj = 0; bj < 2; ++bj) {
                            h8 o;
#pragma unroll
                            for (int n = 0; n < 2; ++n)
#pragma unroll
                                for (int j = 0; j < 4; ++j) o[4 * n + j] = (h16)(acc[ai][bj][m][n][j] + bv);
                            *(h8*)(dst + (size_t)rt * ld + 128 * bj + cw) = o;
                        }
                    }
            }
        }
    } else if (kind == K_DFT || kind == K_CDFT) {
        const float sc = (kind == K_DFT) ? (1.f / 64.f) : (1.f / 16.f);
        const int rstride = (kind == K_DFT) ? 16 : 1;
        const int row0 = (kind == K_DFT) ? (u.aux * 4096 + (pn >> 1)) : (TL + u.aux * 256);
        const int colb = (kind == K_DFT) ? ((pn & 1) * 256) : (pn * 256);
        h16* dst = (h16*)(ws + OFF_FZ) + (size_t)(row0 + rl0 * rstride) * 512 + colb + cw;
#pragma unroll
        for (int ai = 0; ai < 2; ++ai) {
            h8 fz[4][2];
#pragma unroll
            for (int m = 0; m < 4; ++m)
#pragma unroll
                for (int bj = 0; bj < 2; ++bj) fz[m][bj] = *(const h8*)(dst + (size_t)((128 * ai + 16 * m) * rstride) * 512 + 128 * bj);
#pragma unroll
            for (int m = 0; m < 4; ++m)
#pragma unroll
                for (int bj = 0; bj < 2; ++bj) {
                    h16* q = dst + (size_t)((128 * ai + 16 * m) * rstride) * 512 + 128 * bj; h8 o;
#pragma unroll
                    for (int n = 0; n < 2; ++n)
#pragma unroll
                        for (int j = 0; j < 4; ++j) o[4 * n + j] = (h16)(acc[ai][bj][m][n][j] * sc * (float)fz[m][bj][4 * n + j]);
                    *(h8*)q = o;
                }
            asm volatile("" ::: "memory");
        }
    } else if (kind == K_MERGE) {
        const int br = u.aux;
        const h16* gp = (const h16*)(ws + OFF_G) + (size_t)(pm * 256 + rl0) * 3072 + br * 1024 + pn * 256 + cw;
        h16* mp = (h16*)(ws + OFF_M) + (size_t)(pm * 256 + rl0) * 1024 + pn * 256 + cw;
#pragma unroll
        for (int ai = 0; ai < 2; ++ai) {
            h8 ga[4][2], gb[4][2];
#pragma unroll
            for (int m = 0; m < 4; ++m)
#pragma unroll
                for (int bj = 0; bj < 2; ++bj) {
                    const h16* q = gp + (size_t)(128 * ai + 16 * m) * 3072 + 128 * bj;
                    ga[m][bj] = *(const h8*)q;
                    if (br < 2) gb[m][bj] = *(const h8*)(q + 1024);
                }
#pragma unroll
            for (int m = 0; m < 4; ++m)
#pragma unroll
                for (int bj = 0; bj < 2; ++bj) {
                    if (br < 2) {
#pragma unroll
                        for (int n = 0; n < 2; ++n)
#pragma unroll
                            for (int j = 0; j < 4; ++j) acc[ai][bj][m][n][j] *= (float)ga[m][bj][4 * n + j] * __builtin_amdgcn_rcpf((float)gb[m][bj][4 * n + j]);
                    } else {
                        h8 o;
#pragma unroll
                        for (int n = 0; n < 2; ++n)
#pragma unroll
                            for (int j = 0; j < 4; ++j) o[4 * n + j] = (h16)(acc[ai][bj][m][n][j] * (float)ga[m][bj][4 * n + j]);
                        *(h8*)(mp + (size_t)(128 * ai + 16 * m) * 1024 + 128 * bj) = o;
                    }
                }
            asm volatile("" ::: "memory");
        }
    } else {
        const bool lat = pm < TL / 256;
        const float* res; float* dst; const float* gt;
        const float* MOD = (const float*)(ws + OFF_MOD) + (size_t)l * 17 * 3072 + 2048;
        if (lat) {
            const size_t t0 = ((size_t)ch * TL + pm * 256) * 1024;
            res = ((l == 0) ? p.x : p.out) + t0; dst = p.out + t0; gt = MOD + (size_t)(ch * BC + (pm >> 4)) * 3072;
        } else {
            const size_t t0 = ((size_t)ch * TX + (pm - TL / 256) * 256) * 1024;
            res = ((l == 0) ? p.ctx : (const float*)(ws + OFF_CTXR)) + t0; dst = (float*)(ws + OFF_CTXR) + t0; gt = MOD + (size_t)16 * 3072;
        }
        const int c0 = pn * 256 + cw;
        f32x4 gv[2][2];
#pragma unroll
        for (int bj = 0; bj < 2; ++bj)
#pragma unroll
            for (int n = 0; n < 2; ++n) gv[bj][n] = *(const f32x4*)(gt + c0 + 128 * bj + 4 * n);
#pragma unroll
        for (int ai = 0; ai < 2; ++ai) {
            f32x4 r[4][2][2];
#pragma unroll
            for (int m = 0; m < 4; ++m)
#pragma unroll
                for (int bj = 0; bj < 2; ++bj)
#pragma unroll
                    for (int n = 0; n < 2; ++n) r[m][bj][n] = *(const f32x4*)(res + (size_t)(128 * ai + 16 * m + rl0) * 1024 + c0 + 128 * bj + 4 * n);
#pragma unroll
            for (int m = 0; m < 4; ++m)
#pragma unroll
                for (int bj = 0; bj < 2; ++bj)
#pragma unroll
                    for (int n = 0; n < 2; ++n) *(f32x4*)(dst + (size_t)(128 * ai + 16 * m + rl0) * 1024 + c0 + 128 * bj + 4 * n) = r[m][bj][n] + gv[bj][n] * acc[ai][bj][m][n];
            asm volatile("" ::: "memory");
        }
    }
}

__device__ __forceinline__ void gemm_phase(const Params& p, LAS unsigned char* lds, const int kind, const int l, const int ch, const int K, const int tid, const int bid) {
    const int wid = __builtin_amdgcn_readfirstlane(tid >> 6), lane = tid & 63, wr = wid >> 2, wc = wid & 3, fr = lane & 15, fq = lane >> 4;
    const int nt = K / BK;
    unsigned voffA[2], voffB[2];
#pragma unroll
    for (int i = 0; i < 2; ++i) { int R, C; stage_rc(tid * 16 + i * 8192, R, C); const int Rb = (R & ~31) + perm32(R & 31);
        voffA[i] = (unsigned)(R * K + C) * 2u; voffB[i] = (unsigned)(Rb * K + C) * 2u; }
    const size_t kstep = (size_t)(BK * 2);
    const size_t hstep = (size_t)HALF * K * 2;
    const unsigned ldsw = (unsigned)wid * 1024u;
    const int aoff = lds_byte(wr * 64 + fr, fq * 8), boff = lds_byte(wc * 32 + fr, fq * 8);
#define PG8_SA(b, h) (((b) * 2 + (h)) * HTB)
#define PG8_SB(b, h) ((4 + (b) * 2 + (h)) * HTB)
#define PG8_STAGE(bufoff, gbase, voff) do { _Pragma("unroll") for (int _i = 0; _i < 2; ++_i) \
        __builtin_amdgcn_global_load_lds((const unsigned*)((const char*)(gbase) + (voff)[_i]), (LAS unsigned*)(lds + (bufoff) + ldsw + _i * 8192), 16, 0, 0); } while (0)
#define PG8_LDA(dst, b, h) do { _Pragma("unroll") for (int m = 0; m < 4; ++m) _Pragma("unroll") for (int k = 0; k < 2; ++k) dst[m][k] = *(const LAS h8*)(lds + PG8_SA(b, h) + aoff + m * 2048 + k * 1024); } while (0)
#define PG8_LDB(dst, b, h) do { _Pragma("unroll") for (int n = 0; n < 2; ++n) _Pragma("unroll") for (int k = 0; k < 2; ++k) dst[n][k] = *(const LAS h8*)(lds + PG8_SB(b, h) + boff + n * 2048 + k * 1024); } while (0)
#define PG8_MMA(ai, bj, At, Bt) do { __builtin_amdgcn_s_setprio(1); _Pragma("unroll") for (int m = 0; m < 4; ++m) _Pragma("unroll") for (int n = 0; n < 2; ++n) _Pragma("unroll") for (int k = 0; k < 2; ++k) \
        acc[ai][bj][m][n] = __builtin_amdgcn_mfma_f32_16x16x32_f16(Bt[n][k], At[m][k], acc[ai][bj][m][n], 0, 0, 0); __builtin_amdgcn_s_setprio(0); } while (0)
#define PG8_WAIT_V(n) asm volatile("s_waitcnt vmcnt(" #n ")" ::: "memory")
#define PG8_WAIT_L(n) asm volatile("s_waitcnt lgkmcnt(" #n ")" ::: "memory")
#define PG8_BAR __builtin_amdgcn_s_barrier()
#define PG8_SCHED __builtin_amdgcn_sched_barrier(0)
    Unit cur, nxt; int ui = 0;
    if (!sched_next(p, kind, l, 0, cur, bid)) return;
    f32x4 acc[2][2][4][2];
#pragma unroll
    for (int a = 0; a < 2; ++a)
#pragma unroll
        for (int b = 0; b < 2; ++b)
#pragma unroll
            for (int m = 0; m < 4; ++m)
#pragma unroll
                for (int n = 0; n < 2; ++n) acc[a][b][m][n] = (f32x4){0.f, 0.f, 0.f, 0.f};
    h8 At[4][2], B0[2][2], B1[2][2];
    const char* cA = cur.A; const char* cB = cur.B;
    PG8_STAGE(PG8_SB(0, 0), cB, voffB); PG8_STAGE(PG8_SA(0, 0), cA, voffA); PG8_STAGE(PG8_SB(0, 1), cB + hstep, voffB); PG8_STAGE(PG8_SA(0, 1), cA + hstep, voffA);
    if (wr == 1) PG8_BAR;
    PG8_WAIT_V(4); PG8_BAR;
    PG8_STAGE(PG8_SB(1, 0), cB + kstep, voffB); PG8_STAGE(PG8_SA(1, 0), cA + kstep, voffA); PG8_STAGE(PG8_SB(1, 1), cB + hstep + kstep, voffB);
    PG8_WAIT_V(6); PG8_BAR;
    for (;;) {
        const bool has_next = sched_next(p, kind, l, ui + 1, nxt, bid);
        const char* nA = has_next ? nxt.A : cA; const char* nB = has_next ? nxt.B : cB;
        for (int t = 0; t < nt; t += 2) {
            const bool last = (t == nt - 2);
            const char* a1 = cA + (size_t)(t + 1) * kstep;
            const char* a2 = last ? nA : cA + (size_t)(t + 2) * kstep; const char* b2 = last ? nB : cB + (size_t)(t + 2) * kstep;
            const char* a3 = a2 + kstep; const char* b3 = b2 + kstep;
            PG8_LDB(B0, 0, 0); PG8_SCHED; PG8_LDA(At, 0, 0); PG8_STAGE(PG8_SA(1, 1), a1 + hstep, voffA);
            PG8_WAIT_L(8); PG8_BAR; PG8_WAIT_L(0); PG8_MMA(0, 0, At, B0); PG8_BAR; PG8_SCHED;
            PG8_LDB(B1, 0, 1); PG8_STAGE(PG8_SB(0, 0), b2, voffB);
            PG8_BAR; PG8_WAIT_L(0); PG8_MMA(0, 1, At, B1); PG8_BAR;
            PG8_LDA(At, 0, 1); PG8_STAGE(PG8_SA(0, 0), a2, voffA);
            PG8_BAR; PG8_WAIT_L(0); PG8_MMA(1, 0, At, B0); PG8_BAR; PG8_SCHED;
            PG8_STAGE(PG8_SB(0, 1), b2 + hstep, voffB);
            PG8_WAIT_V(6); PG8_BAR; PG8_MMA(1, 1, At, B1); PG8_BAR;
            PG8_LDB(B0, 1, 0); PG8_SCHED; PG8_LDA(At, 1, 0); PG8_STAGE(PG8_SA(0, 1), a2 + hstep, voffA);
            PG8_WAIT_L(8); PG8_BAR; PG8_WAIT_L(0); PG8_MMA(0, 0, At, B0); PG8_BAR; PG8_SCHED;
            PG8_LDB(B1, 1, 1); PG8_STAGE(PG8_SB(1, 0), b3, voffB);
            PG8_BAR; PG8_WAIT_L(0); PG8_MMA(0, 1, At, B1); PG8_BAR;
            PG8_LDA(At, 1, 1); PG8_STAGE(PG8_SA(1, 0), a3, voffA);
            PG8_BAR; PG8_WAIT_L(0); PG8_MMA(1, 0, At, B0); PG8_BAR; PG8_SCHED;
            PG8_STAGE(PG8_SB(1, 1), b3 + hstep, voffB);
            PG8_WAIT_V(6); PG8_BAR; PG8_MMA(1, 1, At, B1); PG8_BAR;
        }
        epilogue(p, kind, l, ch, cur, acc, wr, wc, fr, fq);
        if (!has_next) break;
        if (kind != K_MERGE || cur.aux == 2)
#pragma unroll
        for (int a = 0; a < 2; ++a)
#pragma unroll
            for (int b = 0; b < 2; ++b)
#pragma unroll
                for (int m = 0; m < 4; ++m)
#pragma unroll
                    for (int n = 0; n < 2; ++n) acc[a][b][m][n] = (f32x4){0.f, 0.f, 0.f, 0.f};
        cur = nxt; cA = nA; cB = nB; ++ui;
    }
    PG8_WAIT_V(0);
    if (wr == 0) PG8_BAR;
    PG8_BAR;
#undef PG8_SA
#undef PG8_SB
#undef PG8_STAGE
#undef PG8_LDA
#undef PG8_LDB
#undef PG8_MMA
#undef PG8_WAIT_V
#undef PG8_WAIT_L
#undef PG8_BAR
#undef PG8_SCHED
}

constexpr int N_PHASES = 1 + DEPTH * NCH * 6 + 1;

__global__ void __launch_bounds__(NTHREADS, 2) fwd_megakernel(Params p) {
    extern __shared__ __attribute__((aligned(16))) unsigned char lds_raw[];
    LAS unsigned char* lds = (LAS unsigned char*)lds_raw;
    cg::grid_group grid = cg::this_grid();
    const int wv0 = __builtin_amdgcn_readfirstlane(threadIdx.x >> 6);
    for (int ph = p.ph_lo; ph < p.ph_hi; ++ph) {
        int wvq = wv0; asm volatile("" : "+s"(wvq));
        int lnq; asm volatile("v_mbcnt_lo_u32_b32 %0, -1, 0\n\tv_mbcnt_hi_u32_b32 %0, -1, %0" : "=v"(lnq));
        int tid = (wvq << 6) | lnq, bid = blockIdx.x;
#define LAUNDER() do { asm volatile("" : "+v"(tid)); asm volatile("" : "+s"(bid)); } while (0)
        LAUNDER();
        if (ph == 0) {
            for (int rep = 0; rep < 1 + REP_P0; ++rep) { LAUNDER(); p0_prologue(p, lds, tid, bid); }
        } else if (ph == N_PHASES - 1) {
            pf_final(p, tid, bid);
        } else {
            const int q = ph - 1, s = q % 6, lc = q / 6, ch = lc % NCH, l = lc / NCH;
            if (s == 0) p1_norm(p, l, ch, tid, bid);
            else if (s == 1) { for (int rep = 0; rep < 1 + REP_P2; ++rep) { LAUNDER(); gemm_phase(p, lds, K_IN, l, ch, 1024, tid, bid); } }
            else if (s == 2) {
                p3_dft1(p, tid, bid);
                if (l < DEPTH - 1) gemm_phase(p, lds, K_CDFT, l, ch, 512, tid, bid);
                p3_conv(p, l, tid, bid);
                p3_attn(p, l, (LAS float*)(lds + LDS_STAGE), tid, bid, false);
            }
            else if (s == 3) gemm_phase(p, lds, K_DFT, l, ch, 512, tid, bid);
            else if (s == 4) { for (int rep = 0; rep < 1 + REP_P4; ++rep) { LAUNDER(); gemm_phase(p, lds, K_MERGE, l, ch, 512, tid, bid); } }
            else gemm_phase(p, lds, K_OUT, l, ch, 1024, tid, bid);
        }
        if (ph + 1 < p.ph_hi) grid.sync();
    }
}

extern "C" void kernel_launch(void* const* d_in, const int* in_sizes, int n_in, void* d_out, int out_size, void* d_ws, size_t ws_size, hipStream_t stream) {
    static int grid_blocks = 0;
    if (!grid_blocks) {
        int dev = 0, cus = 0, per_cu = 0;
        hipGetDevice(&dev);
        hipDeviceGetAttribute(&cus, hipDeviceAttributeMultiprocessorCount, dev);
        if (hipFuncSetAttribute((const void*)fwd_megakernel, hipFuncAttributeMaxDynamicSharedMemorySize, LDS_BYTES) != hipSuccess) fprintf(stderr, "kernel_launch: hipFuncSetAttribute failed\n");
        hipOccupancyMaxActiveBlocksPerMultiprocessor(&per_cu, (const void*)fwd_megakernel, NTHREADS, LDS_BYTES);
        if (per_cu < 1) { fprintf(stderr, "kernel_launch: occupancy query says %d blocks/CU\n", per_cu); per_cu = 1; }
        (void)hipGetLastError();
        grid_blocks = cus * per_cu;
        if (ws_size < WS_END) fprintf(stderr, "kernel_launch: workspace too small: %zu < %zu\n", ws_size, (size_t)WS_END);
    }
    Params p{};
    const float** f = (const float**)&p;
    for (int i = 0; i < 17; ++i) f[i] = (const float*)d_in[i];
    p.out = (float*)d_out; p.ws = (unsigned char*)d_ws;
#if MULTI_LAUNCH
    for (int ph = 0; ph < N_PHASES; ++ph) {
        p.ph_lo = ph; p.ph_hi = ph + 1;
        hipLaunchKernelGGL(fwd_megakernel, dim3(grid_blocks), dim3(NTHREADS), LDS_BYTES, stream, p);
    }
#else
    p.ph_lo = 0; p.ph_hi = N_PHASES;
    void* args[] = {&p};
    hipError_t e = hipLaunchCooperativeKernel((const void*)fwd_megakernel, dim3(grid_blocks), dim3(NTHREADS), args, LDS_BYTES, stream);
    if (e != hipSuccess) fprintf(stderr, "cooperative launch failed: %s (grid %d)\n", hipGetErrorString(e), grid_blocks);
#endif
}
```

```cpp
#include <hip/hip_runtime.h>
#include <hip/hip_cooperative_groups.h>
#include <cstdio>
namespace cg = cooperative_groups;

#define LAS __attribute__((address_space(3)))
typedef _Float16 h16;
typedef _Float16 h8 __attribute__((ext_vector_type(8)));
typedef _Float16 h4 __attribute__((ext_vector_type(4)));
typedef float f32x4 __attribute__((ext_vector_type(4)));

#ifndef MULTI_LAUNCH
#define MULTI_LAUNCH 0
#endif
#define REP_P0 0
#define REP_P2 0
#define REP_P4 0

constexpr int DM = 1024, NBATCH = 16, SEQ = 4096, DEPTH = 4, CTXL = 256, DIN = 8192;
constexpr int BC = 8, NCH = 2;
constexpr int TL = BC * SEQ, TX = BC * CTXL, TC = TL + TX;
constexpr int NIN = 8704;
constexpr int NTHREADS = 512;
constexpr int LDS_STAGE = 131072, LDS_BYTES = LDS_STAGE + 16384;

constexpr size_t al256(size_t x) { return (x + 255) & ~(size_t)255; }
constexpr size_t OFF_WIN = 0;
constexpr size_t OFF_BIN = al256(OFF_WIN + (size_t)DEPTH * NIN * 1024 * 2);
constexpr size_t OFF_WBR = al256(OFF_BIN + (size_t)DEPTH * NIN * 4);
constexpr size_t OFF_WOUT = al256(OFF_WBR + (size_t)DEPTH * 3 * 1024 * 512 * 2);
constexpr size_t OFF_CS = al256(OFF_WOUT + (size_t)DEPTH * 1024 * 1024 * 2);
constexpr size_t OFF_CS2 = al256(OFF_CS + (size_t)16 * 256 * 2 * 4);
constexpr size_t OFF_MOD = al256(OFF_CS2 + (size_t)256 * 512 * 2);
constexpr size_t OFF_CTXR = al256(OFF_MOD + (size_t)DEPTH * 17 * 3072 * 4);
constexpr size_t OFF_H = al256(OFF_CTXR + (size_t)NBATCH * CTXL * 1024 * 4);
constexpr size_t OFF_M = al256(OFF_H + (size_t)TC * 1024 * 2);
constexpr size_t SZ512 = (size_t)TC * 512 * 2;
constexpr size_t OFF_CX = al256(OFF_M + (size_t)TC * 1024 * 2);
constexpr size_t OFF_BZ = al256(OFF_CX + SZ512);
constexpr size_t OFF_FZ = al256(OFF_BZ + SZ512);
constexpr size_t OFF_Q = al256(OFF_FZ + SZ512);
constexpr size_t OFF_K = al256(OFF_Q + SZ512);
constexpr size_t OFF_CZ = al256(OFF_K + SZ512);
constexpr size_t OFF_AACT = al256(OFF_CZ + SZ512);
constexpr size_t OFF_G = al256(OFF_AACT + SZ512);
constexpr size_t OFF_VTL = al256(OFF_G + (size_t)TC * 3072 * 2);
constexpr size_t OFF_VTC = al256(OFF_VTL + (size_t)BC * 512 * 8192 * 2);
constexpr size_t OFF_VF = al256(OFF_VTC + (size_t)BC * 512 * 512 * 2);
constexpr size_t OFF_BAR = al256(OFF_VF + SZ512);
constexpr size_t WS_END = al256(OFF_BAR + 256);

struct Params {
    const float *x, *c, *ctx, *c_ctx, *norm_g, *w_ada, *b_ada, *w_in, *b_in, *w_conv, *b_conv, *rpb, *w_br_a, *w_br_f, *w_br_c, *w_out, *final_g;
    float* out; unsigned char* ws; int ph_lo, ph_hi;
};

__device__ __forceinline__ float shx(float v, int m, int lane) { return __int_as_float(__builtin_amdgcn_ds_bpermute((lane ^ m) << 2, __float_as_int(v))); }
__device__ __forceinline__ float silu_f(float v) { return v * __builtin_amdgcn_rcpf(1.f + __expf(-v)); }
__device__ __forceinline__ float sigm_f(float v) { return __builtin_amdgcn_rcpf(1.f + __expf(-v)); }

__device__ __forceinline__ int in_col(int n) {
    const int j = n >> 8, w = n & 255;
    if (j < 4) return (w < 128) ? (128 * j + w) : (1024 + 128 * j + (w - 128));
    if (j < 8) return (w < 128) ? (512 + 128 * (j - 4) + w) : (1536 + 128 * (j - 4) + (w - 128));
    if (j < 10) return 2560 + (j - 8) * 256 + w;
    if (j < 12) return 3072 + (j - 10) * 256 + w;
    if (j < 14) return 3584 + (j - 12) * 256 + w;
    if (j < 16) return 4608 + (j - 14) * 256 + w;
    if (j < 28) return 5120 + (j - 16) * 256 + w;
    return 4096 + (n - 7168);
}

template <bool PERMCOL>
__device__ __forceinline__ void transpose_tile(const int tid, const float* __restrict__ src, int lds_, h16* __restrict__ dst, int ldd, int k0, int n0, LAS float* t) {
    const int a = tid & 63, b = tid >> 6;
    const int col = PERMCOL ? in_col(n0 + a) : (n0 + a);
#pragma unroll
    for (int it = 0; it < 8; ++it) { const int k = b + it * 8; t[k * 65 + a] = src[(size_t)(k0 + k) * lds_ + col]; }
    __syncthreads();
#pragma unroll
    for (int it = 0; it < 8; ++it) { const int n = b + it * 8; dst[(size_t)(n0 + n) * ldd + k0 + a] = (h16)t[a * 65 + n]; }
    __syncthreads();
}

__device__ __forceinline__ void p0_prologue(const Params& p, LAS unsigned char* lds, const int tid, const int bid) {
    const int G = gridDim.x;
    unsigned char* ws = p.ws;
    LAS float* lf = (LAS float*)lds;
    constexpr int N_MOD = DEPTH * 24;
    constexpr int N_TIN = DEPTH * 120 * 16;
    constexpr int N_FOU = DEPTH * 1024;
    constexpr int N_BIAS = DEPTH;
    constexpr int N_TBR = DEPTH * 3 * 16 * 8;
    constexpr int N_TOUT = DEPTH * 16 * 16;
    constexpr int N_CS = 8;
    constexpr int N_CS2 = 32;
    constexpr int E0 = N_MOD, E1 = E0 + N_TIN, E2 = E1 + N_FOU, E3 = E2 + N_BIAS, E4 = E3 + N_TBR, E5 = E4 + N_TOUT, E6 = E5 + N_CS, E7 = E6 + N_CS2;
    for (int it = bid; it < E7; it += G) {
        if (it < E0) {
            const int l = it / 24, cb = it % 24;
            for (int i = tid; i < 17 * 1024; i += NTHREADS) { const float v = (i < 16 * 1024) ? p.c[i] : p.c_ctx[i - 16 * 1024]; lf[i] = silu_f(v); }
            __syncthreads();
            const int col = cb * 128 + (tid & 127), kq = tid >> 7;
            float acc[17];
#pragma unroll
            for (int j = 0; j < 17; ++j) acc[j] = 0.f;
            const float* wp = p.w_ada + (size_t)l * 1024 * 3072 + col;
            for (int k = kq * 256; k < kq * 256 + 256; ++k) {
                const float w = wp[(size_t)k * 3072];
#pragma unroll
                for (int j = 0; j < 17; ++j) acc[j] += lf[j * 1024 + k] * w;
            }
            LAS float* red = lf + 17 * 1024;
#pragma unroll
            for (int j = 0; j < 17; ++j) red[(kq * 17 + j) * 128 + (tid & 127)] = acc[j];
            __syncthreads();
            float* MOD = (float*)(ws + OFF_MOD);
            for (int i = tid; i < 17 * 128; i += NTHREADS) {
                const int j = i >> 7, cc = i & 127;
                const float s = red[(0 * 17 + j) * 128 + cc] + red[(1 * 17 + j) * 128 + cc] + red[(2 * 17 + j) * 128 + cc] + red[(3 * 17 + j) * 128 + cc];
                MOD[((size_t)l * 17 + j) * 3072 + cb * 128 + cc] = s + p.b_ada[l * 3072 + cb * 128 + cc];
            }
            __syncthreads();
        } else if (it < E1) {
            const int t = it - E0, l = t / (120 * 16), r = t % (120 * 16), nt = r / 16, kt = r % 16;
            transpose_tile<true>(tid, p.w_in + (size_t)l * 1024 * DIN, DIN, (h16*)(ws + OFF_WIN) + (size_t)l * NIN * 1024, 1024, kt * 64, nt * 64, lf);
        } else if (it < E2) {
            const int t = it - E1, l = t >> 10, k = t & 1023;
            lf[tid] = p.w_in[((size_t)l * 1024 + k) * DIN + 2048 + tid];
            if (tid < 128) { lf[512 + tid] = cospif((float)tid * (1.f / 64.f)); lf[640 + tid] = sinpif((float)tid * (1.f / 64.f)); }
            __syncthreads();
            const int g = tid >> 7, kk = tid & 127;
            float re = 0.f, im = 0.f;
            for (int n2 = 0; n2 < 128; ++n2) { const float w = lf[g * 128 + n2]; const int ix = (n2 * kk) & 127; re += w * lf[512 + ix]; im -= w * lf[640 + ix]; }
            h16* W = (h16*)(ws + OFF_WIN) + (size_t)l * NIN * 1024;
            W[(size_t)(7680 + tid) * 1024 + k] = (h16)(re * 0.08838834764831845f);
            W[(size_t)(7680 + 512 + tid) * 1024 + k] = (h16)(im * 0.08838834764831845f);
            __syncthreads();
        } else if (it < E3) {
            const int l = it - E2;
            float* B = (float*)(ws + OFF_BIN) + (size_t)l * NIN;
            const float* bi = p.b_in + (size_t)l * DIN;
            for (int n = tid; n < 7680; n += NTHREADS) B[n] = bi[in_col(n)];
            const int g = tid >> 7, kk = tid & 127;
            float re = 0.f, im = 0.f;
            for (int n2 = 0; n2 < 128; ++n2) { const float w = bi[2048 + g * 128 + n2]; const float ang = (float)((n2 * kk) & 127) * (1.f / 64.f); re += w * cospif(ang); im -= w * sinpif(ang); }
            B[7680 + tid] = re * 0.08838834764831845f; B[7680 + 512 + tid] = im * 0.08838834764831845f;
        } else if (it < E4) {
            const int t = it - E3, lb = t / 128, r = t % 128, nt = r / 8, kt = r % 8, l = lb / 3, br = lb % 3;
            const float* src = (br == 0 ? p.w_br_a : (br == 1 ? p.w_br_f : p.w_br_c)) + (size_t)l * 512 * 1024;
            transpose_tile<false>(tid, src, 1024, (h16*)(ws + OFF_WBR) + (size_t)lb * 1024 * 512, 512, kt * 64, nt * 64, lf);
        } else if (it < E5) {
            const int t = it - E4, l = t / 256, r = t % 256, nt = r / 16, kt = r % 16;
            transpose_tile<false>(tid, p.w_out + (size_t)l * 1024 * 1024, 1024, (h16*)(ws + OFF_WOUT) + (size_t)l * 1024 * 1024, 1024, kt * 64, nt * 64, lf);
        } else if (it < E6) {
            const int e = (it - E5) * NTHREADS + tid, k1 = e >> 8, n2 = e & 255;
            const float ang = (float)(k1 * n2) * (1.f / 2048.f);
            float* TW = (float*)(ws + OFF_CS);
            TW[2 * e] = cospif(ang); TW[2 * e + 1] = sinpif(ang);
        } else {
            const size_t e0 = ((size_t)(it - E6) * NTHREADS + tid) * 8;
            const int k1 = (int)(e0 >> 9), j0 = (int)(e0 & 511);
            h8 o;
#pragma unroll
            for (int j = 0; j < 8; ++j) { const int jj = j0 + j, pos = jj & 255; const float ang = (float)((k1 * pos) & 255) * (1.f / 128.f); o[j] = (h16)((jj < 256) ? cospif(ang) : sinpif(ang)); }
            *(h8*)((h16*)(ws + OFF_CS2) + e0) = o;
        }
    }
}

__device__ __forceinline__ void p1_norm(const Params& p, int l, int ch, const int tid, const int bid) {
    const int lane = tid & 63, wid = tid >> 6;
    unsigned char* ws = p.ws;
    const float* xsrc = (l == 0) ? p.x : p.out;
    const float* csrc = (l == 0) ? p.ctx : (const float*)(ws + OFF_CTXR);
    const float* MOD = (const float*)(ws + OFF_MOD) + (size_t)l * 17 * 3072;
    const float* ng = p.norm_g + l * 1024;
    h16* H = (h16*)(ws + OFF_H);
    for (int row = bid * 8 + wid; row < TC; row += gridDim.x * 8) {
        const float* src = (row < TL) ? xsrc + ((size_t)ch * TL + row) * 1024 : csrc + ((size_t)ch * TX + (row - TL)) * 1024;
        const float* mod = MOD + (size_t)((row < TL) ? (ch * BC + (row >> 12)) : 16) * 3072;
        f32x4 v[4]; float ss = 0.f;
#pragma unroll
        for (int it = 0; it < 4; ++it) { v[it] = *(const f32x4*)(src + it * 256 + lane * 4); ss += v[it][0] * v[it][0] + v[it][1] * v[it][1] + v[it][2] * v[it][2] + v[it][3] * v[it][3]; }
#pragma unroll
        for (int o = 32; o >= 1; o >>= 1) ss += shx(ss, o, lane);
        const float inv = rsqrtf(ss * (1.f / 1024.f) + 1e-6f);
#pragma unroll
        for (int it = 0; it < 4; ++it) {
            const int c = it * 256 + lane * 4;
            const f32x4 g = *(const f32x4*)(ng + c), sh = *(const f32x4*)(mod + c), sc = *(const f32x4*)(mod + 1024 + c);
            h4 o;
#pragma unroll
            for (int j = 0; j < 4; ++j) o[j] = (h16)(v[it][j] * inv * g[j] * (1.f + sc[j]) + sh[j]);
            *(h4*)(H + (size_t)row * 1024 + c) = o;
        }
    }
}

__device__ __forceinline__ void pf_final(const Params& p, const int tid, const int bid) {
    const int lane = tid & 63, wid = tid >> 6;
    for (int row = bid * 8 + wid; row < NBATCH * SEQ; row += gridDim.x * 8) {
        float* src = p.out + (size_t)row * 1024;
        f32x4 v[4]; float ss = 0.f;
#pragma unroll
        for (int it = 0; it < 4; ++it) { v[it] = *(const f32x4*)(src + it * 256 + lane * 4); ss += v[it][0] * v[it][0] + v[it][1] * v[it][1] + v[it][2] * v[it][2] + v[it][3] * v[it][3]; }
#pragma unroll
        for (int o = 32; o >= 1; o >>= 1) ss += shx(ss, o, lane);
        const float inv = rsqrtf(ss * (1.f / 1024.f) + 1e-6f);
#pragma unroll
        for (int it = 0; it < 4; ++it) { const int c = it * 256 + lane * 4; const f32x4 g = *(const f32x4*)(p.final_g + c); *(f32x4*)(src + c) = v[it] * inv * g; }
    }
}

__device__ __forceinline__ void p3_conv(const Params& p, int l, const int tid, const int bid) {
    unsigned char* ws = p.ws;
    const h16* CX = (const h16*)(ws + OFF_CX); const h16* BZ = (const h16*)(ws + OFF_BZ); h16* AA = (h16*)(ws + OFF_AACT);
    const float* wc = p.w_conv + (size_t)l * 3 * 512; const float* bc = p.b_conv + (size_t)l * 512;
    const int nrows = (l == DEPTH - 1) ? TL : TC;
    for (int idx = bid * NTHREADS + tid; idx < nrows * 64; idx += gridDim.x * NTHREADS) {
        const int row = idx >> 6, c8 = (idx & 63) * 8;
        const int pos = (row < TL) ? (row & 4095) : ((row - TL) & 255), L = (row < TL) ? 4096 : 256;
        const h8 z = {0, 0, 0, 0, 0, 0, 0, 0};
        const h8 cur = *(const h8*)(CX + (size_t)row * 512 + c8);
        const h8 prv = (pos > 0) ? *(const h8*)(CX + (size_t)(row - 1) * 512 + c8) : z;
        const h8 nxt = (pos < L - 1) ? *(const h8*)(CX + (size_t)(row + 1) * 512 + c8) : z;
        const h8 bz = *(const h8*)(BZ + (size_t)row * 512 + c8);
        h8 o;
#pragma unroll
        for (int j = 0; j < 8; ++j) {
            const float cv = wc[c8 + j] * (float)prv[j] + wc[512 + c8 + j] * (float)cur[j] + wc[1024 + c8 + j] * (float)nxt[j] + bc[c8 + j];
            o[j] = (h16)((float)bz[j] * cv);
        }
        *(h8*)(AA + (size_t)row * 512 + c8) = o;
    }
}

__device__ __forceinline__ const h16* katt(const h16* Kb, int keytok, int h, int fq) { return Kb + ((size_t)((keytok >> 3) * 8 + h) * 8 + fq) * 64 + (keytok & 7) * 8; }
__device__ __forceinline__ const h16* vatt(const h16* VF, int tk, int h, int dt, int fr) { return VF + ((size_t)((tk >> 3) * 8 + h) * 4 + dt) * 128 + (((tk >> 2) & 1) * 16 + fr) * 4; }

template <bool LAT>
__device__ __forceinline__ void attn_unit(const h16* Qb, const h16* Kb, const h16* VF, h16* CZ, const LAS float* rpbL, const int bb, const int h, const int r, const int n, const int tokQ0, const int fr, const int fq, const int lane, const bool dummy) {
    constexpr int NT = LAT ? 32 : 16, NKB = NT / 4, NP = NT / 2, NVB = NP / 4;
    const f32x4 zero4 = {0.f, 0.f, 0.f, 0.f};
    const int tokQ = tokQ0 + fr;
    const h16* qp = Qb + (size_t)tokQ * 512 + h * 64 + fq * 8;
    const h8 q0 = *(const h8*)qp, q1 = *(const h8*)(qp + 32);
    int kcs = n * 16 - 8; kcs = kcs < 0 ? 0 : (kcs > 32 ? 32 : kcs);
    int rs = r - 4; rs = rs < 0 ? 0 : (rs > 56 ? 56 : rs);
    const int qcol = n * 16 + fr; int cs = qcol - 8; cs = cs < 0 ? 0 : (cs > 48 ? 48 : cs);
#define ATT_TOK(t) ((LAT && (t) < 16) ? (bb * 4096 + (rs + ((t) >> 1)) * 64 + kcs + 16 * ((t) & 1)) : (TL + bb * 256 + ((t) - (LAT ? 16 : 0)) * 16))
    f32x4 s[NT];
    h8 kb[2][4][2];
#pragma unroll
    for (int tt = 0; tt < 4; ++tt) { const h16* kp = katt(Kb, ATT_TOK(tt) + fr, h, fq); kb[0][tt][0] = *(const h8*)kp; kb[0][tt][1] = *(const h8*)(kp + 256); }
#pragma unroll
    for (int b = 0; b < NKB; ++b) {
        if (b + 1 < NKB) {
#pragma unroll
            for (int tt = 0; tt < 4; ++tt) { const int t = (b + 1) * 4 + tt; const h16* kp = katt(Kb, ATT_TOK(t) + fr, h, fq); kb[(b + 1) & 1][tt][0] = *(const h8*)kp; kb[(b + 1) & 1][tt][1] = *(const h8*)(kp + 256); }
        }
        __builtin_amdgcn_sched_barrier(0);
#pragma unroll
        for (int tt = 0; tt < 4; ++tt) {
            const int t = b * 4 + tt;
            f32x4 a = zero4;
            a = __builtin_amdgcn_mfma_f32_16x16x32_f16(kb[b & 1][tt][0], q0, a, 0, 0, 0);
            a = __builtin_amdgcn_mfma_f32_16x16x32_f16(kb[b & 1][tt][1], q1, a, 0, 0, 0);
            if (LAT && t < 16) {
                const int i = t >> 1, par = t & 1;
                const int kc0 = kcs + 16 * par + 4 * fq;
                const LAS float* bp = rpbL + (h * 15 + (rs + i - r + 7)) * 31;
#pragma unroll
                for (int j = 0; j < 4; ++j) {
                    const int kcol = kc0 + j; const bool ok = (kcol >= cs) && (kcol < cs + 16);
                    int dc = kcol - qcol + 15; dc = dc < 0 ? 0 : (dc > 30 ? 30 : dc);
                    a[j] = ok ? a[j] + bp[dc] : -1e30f;
                }
            }
            s[t] = a;
        }
        __builtin_amdgcn_sched_barrier(0);
    }
    h4 vb[2][4][4][2];
#pragma unroll
    for (int pp = 0; pp < 4; ++pp)
#pragma unroll
        for (int dt = 0; dt < 4; ++dt) { const int tk = ATT_TOK(2 * pp) + 4 * fq; vb[0][pp][dt][0] = *(const h4*)vatt(VF, tk, h, dt, fr); vb[0][pp][dt][1] = *(const h4*)vatt(VF, tk + 16, h, dt, fr); }
    __builtin_amdgcn_sched_barrier(0);
    float mx = -3e38f;
#pragma unroll
    for (int t = 0; t < NT; ++t) mx = fmaxf(mx, fmaxf(fmaxf(s[t][0], s[t][1]), fmaxf(s[t][2], s[t][3])));
    mx = fmaxf(mx, shx(mx, 16, lane)); mx = fmaxf(mx, shx(mx, 32, lane));
    float sum = 0.f;
    h8 pf[NP];
#pragma unroll
    for (int tp = 0; tp < NP; ++tp) {
#pragma unroll
        for (int j = 0; j < 4; ++j) {
            const float e0 = __expf(s[2 * tp][j] - mx), e1 = __expf(s[2 * tp + 1][j] - mx);
            sum += e0 + e1; pf[tp][j] = (h16)e0; pf[tp][4 + j] = (h16)e1;
        }
    }
    sum += shx(sum, 16, lane); sum += shx(sum, 32, lane);
    f32x4 o[4] = {zero4, zero4, zero4, zero4};
#pragma unroll
    for (int b = 0; b < NVB; ++b) {
        if (b + 1 < NVB) {
#pragma unroll
            for (int pp = 0; pp < 4; ++pp)
#pragma unroll
                for (int dt = 0; dt < 4; ++dt) { const int tk = ATT_TOK(2 * ((b + 1) * 4 + pp)) + 4 * fq; vb[(b + 1) & 1][pp][dt][0] = *(const h4*)vatt(VF, tk, h, dt, fr); vb[(b + 1) & 1][pp][dt][1] = *(const h4*)vatt(VF, tk + 16, h, dt, fr); }
        }
        __builtin_amdgcn_sched_barrier(0);
#pragma unroll
        for (int pp = 0; pp < 4; ++pp)
#pragma unroll
            for (int dt = 0; dt < 4; ++dt) {
                const h4 v0 = vb[b & 1][pp][dt][0], v1 = vb[b & 1][pp][dt][1];
                const h8 vf = {v0[0], v0[1], v0[2], v0[3], v1[0], v1[1], v1[2], v1[3]};
                o[dt] = __builtin_amdgcn_mfma_f32_16x16x32_f16(vf, pf[b * 4 + pp], o[dt], 0, 0, 0);
            }
        __builtin_amdgcn_sched_barrier(0);
    }
#undef ATT_TOK
    const float inv = 1.f / sum;
#pragma unroll
    for (int dt = 0; dt < 4; ++dt) {
        h16* cp = CZ + (size_t)tokQ * 512 + h * 64 + 16 * dt + 4 * fq;
        const h4 cz = *(const h4*)cp; h4 ov;
#pragma unroll
        for (int j = 0; j < 4; ++j) ov[j] = (h16)(o[dt][j] * inv * (float)cz[j]);
        *(h4*)cp = ov;
    }
}

__device__ __forceinline__ void p3_attn(const Params& p, int l, LAS float* rpbL, const int tid, const int bid, const bool dummy) {
    const int lane = tid & 63, wid = tid >> 6, fr = lane & 15, fq = lane >> 4;
    unsigned char* ws = p.ws;
    const h16* Qb = (const h16*)(ws + OFF_Q); const h16* Kb = (const h16*)(ws + OFF_K);
    const h16* VF = (const h16*)(ws + OFF_VF);
    h16* CZ = (h16*)(ws + OFF_CZ);
    for (int i = tid; i < 8 * 15 * 31; i += NTHREADS) rpbL[i] = p.rpb[(size_t)l * 8 * 15 * 31 + i];
    __syncthreads();
    for (int u = bid * 8 + wid; u < BC * 8 * 64 * 4; u += gridDim.x * 8) {
        const int n = u & 3, r = (u >> 2) & 63, h = (u >> 8) & 7, bb = u >> 11;
        attn_unit<true>(Qb, Kb, VF, CZ, rpbL, bb, h, r, n, bb * 4096 + r * 64 + n * 16, fr, fq, lane, dummy);
    }
    if (l < DEPTH - 1) {
        for (int u = bid * 8 + wid; u < BC * 8 * 16; u += gridDim.x * 8) {
            const int qg = u & 15, h = (u >> 4) & 7, bb = u >> 7;
            attn_unit<false>(Qb, Kb, VF, CZ, rpbL, bb, h, 0, 0, TL + bb * 256 + qg * 16, fr, fq, lane, dummy);
        }
    }
}

__device__ __forceinline__ void dft4(f32x4& r0, f32x4& i0, f32x4& r1, f32x4& i1, f32x4& r2, f32x4& i2, f32x4& r3, f32x4& i3) {
    const f32x4 t0r = r0 + r2, t0i = i0 + i2, t1r = r0 - r2, t1i = i0 - i2, t2r = r1 + r3, t2i = i1 + i3, t3r = r1 - r3, t3i = i1 - i3;
    r0 = t0r + t2r; i0 = t0i + t2i; r2 = t0r - t2r; i2 = t0i - t2i;
    r1 = t1r + t3i; i1 = t1i - t3r; r3 = t1r - t3i; i3 = t1i + t3r;
}
__device__ __forceinline__ void cmulc(f32x4& r, f32x4& i, const float wr, const float wi) { const f32x4 a = r * wr - i * wi, b = r * wi + i * wr; r = a; i = b; }
__device__ __forceinline__ void p3_dft1(const Params& p, const int tid, const int bid) {
    unsigned char* ws = p.ws;
    const h16* VT = (const h16*)(ws + OFF_VTL); h16* TP = (h16*)(ws + OFF_H); const float* TW = (const float*)(ws + OFF_CS);
    constexpr float C1 = 0.92387953251f, S1 = 0.38268343237f, C2 = 0.70710678119f;
    for (int idx = bid * NTHREADS + tid; idx < BC * 512 * 64; idx += gridDim.x * NTHREADS) {
        const int q4 = idx & 63, c = (idx >> 6) & 511, bb = idx >> 15, n2 = 4 * q4;
        const h16* src = VT + (size_t)(bb * 512 + c) * 8192 + n2;
        f32x4 xr[16], xi[16];
#pragma unroll
        for (int n1 = 0; n1 < 16; ++n1) {
            const h4 a = *(const h4*)(src + 256 * n1), b = *(const h4*)(src + 4096 + 256 * n1);
#pragma unroll
            for (int j = 0; j < 4; ++j) { xr[n1][j] = (float)a[j]; xi[n1][j] = (float)b[j]; }
        }
#pragma unroll
        for (int b = 0; b < 4; ++b) dft4(xr[b], xi[b], xr[4 + b], xi[4 + b], xr[8 + b], xi[8 + b], xr[12 + b], xi[12 + b]);
        cmulc(xr[5], xi[5], C1, -S1);
        cmulc(xr[6], xi[6], C2, -C2);
        cmulc(xr[7], xi[7], S1, -C1);
        cmulc(xr[9], xi[9], C2, -C2);
        cmulc(xr[10], xi[10], 0.f, -1.f);
        cmulc(xr[11], xi[11], -C2, -C2);
        cmulc(xr[13], xi[13], S1, -C1);
        cmulc(xr[14], xi[14], -C2, -C2);
        cmulc(xr[15], xi[15], -C1, S1);
#pragma unroll
        for (int cc = 0; cc < 4; ++cc) dft4(xr[4 * cc], xi[4 * cc], xr[4 * cc + 1], xi[4 * cc + 1], xr[4 * cc + 2], xi[4 * cc + 2], xr[4 * cc + 3], xi[4 * cc + 3]);
#pragma unroll
        for (int k1 = 0; k1 < 16; ++k1) {
            const int ix = 4 * (k1 & 3) + (k1 >> 2);
            const f32x4 t0 = *(const f32x4*)(TW + 2 * (k1 * 256 + n2)), t1 = *(const f32x4*)(TW + 2 * (k1 * 256 + n2) + 4);
            const f32x4 tr = {t0[0], t0[2], t1[0], t1[2]}, ti = {t0[1], t0[3], t1[1], t1[3]};
            const f32x4 rr = xr[ix] * tr + xi[ix] * ti, ii = xi[ix] * tr - xr[ix] * ti;
            h4 orr, oii;
#pragma unroll
            for (int j = 0; j < 4; ++j) { orr[j] = (h16)rr[j]; oii[j] = (h16)ii[j]; }
            h16* dst = TP + ((size_t)((bb * 16 + k1) * 512 + c)) * 512 + n2;
            *(h4*)dst = orr; *(h4*)(dst + 256) = oii;
        }
    }
}

constexpr int BM = 256, BK = 64, HALF = 128, HTB = HALF * BK * 2;
enum { K_IN = 0, K_DFT = 1, K_CDFT = 2, K_MERGE = 3, K_OUT = 4 };
struct Unit { const char* A; const char* B; int pm, pn, aux; };

__device__ __forceinline__ int lds_byte(int r, int c) { const int st = (r >> 4) * 2 + (c >> 5), rr = r & 15, cc = c & 31, ob = rr * 64 + cc * 2; return st * 1024 + (ob ^ (((ob >> 9) & 1) << 5)); }
__device__ __forceinline__ void stage_rc(int b, int& R, int& C) { const int st = b / 1024, sb = b % 1024, swz = sb ^ (((sb >> 9) & 1) << 5); R = (st >> 1) * 16 + swz / 64; C = (st & 1) * 32 + (swz % 64) / 2; }
__device__ __forceinline__ int perm32(int rho) { const int n = rho >> 4, i = rho & 15; return 8 * (i >> 2) + 4 * n + (i & 3); }

__device__ __forceinline__ bool sched_next(const Params& p, const int kind, const int l, const int i, Unit& u, const int bid) {
    const int G = gridDim.x, c = bid;
    const char* ws = (const char*)p.ws;
    if (kind == K_IN) {
        constexpr int nM = TC / 256, nN = NIN / 256, nwg = nM * nN;
        const long L = (long)i * G + c; if (L >= nwg) return false;
        int wgid = (int)L; { const int q = nwg / 8, r = nwg % 8, xcd = wgid % 8, off = wgid / 8; wgid = (xcd < r ? xcd * (q + 1) : r * (q + 1) + (xcd - r) * q) + off; }
        const int nig = 8 * nN, gid = wgid / nig, fm = gid * 8, gsz = (nM - fm) < 8 ? (nM - fm) : 8;
        const int pm = fm + ((wgid % nig) % gsz), pn = (wgid % nig) / gsz;
        const char* Hp = ws + OFF_H + (size_t)pm * 256 * 1024 * 2;
        const char* Wp = ws + OFF_WIN + ((size_t)l * NIN + pn * 256) * 1024 * 2;
        if (pn < 28) { u.A = Hp; u.B = Wp; } else { u.A = Wp; u.B = Hp; }
        u.pm = pm; u.pn = pn; u.aux = 0; return true;
    } else if (kind == K_DFT) {
        const int L = i * G + c; if (L >= BC * 32) return false;
        const int bb = L & 7, pn = L >> 3;
        u.A = ws + OFF_CS2; u.B = ws + OFF_H + ((size_t)bb * 8192 + pn * 256) * 512 * 2;
        u.pm = 0; u.pn = pn; u.aux = bb; return true;
    } else if (kind == K_CDFT) {
        const int L = i * G + c; if (L >= BC * 2) return false;
        const int bb = L >> 1, pn = L & 1;
        u.A = ws + OFF_CS2; u.B = ws + OFF_VTC + ((size_t)(bb * 512 + pn * 256)) * 512 * 2;
        u.pm = 0; u.pn = pn; u.aux = bb; return true;
    } else if (kind == K_MERGE) {
        const int ntile = ((l == DEPTH - 1) ? TL / 256 : TC / 256) * 4;
        const int ti = (i / 3) * G + c, br = i % 3; if (ti >= ntile) return false;
        const int pm = ti >> 2, pn = ti & 3;
        const size_t aoff = (br == 0) ? OFF_AACT : (br == 1 ? OFF_FZ : OFF_CZ);
        u.A = ws + aoff + (size_t)pm * 256 * 512 * 2; u.B = ws + OFF_WBR + ((size_t)((l * 3 + br) * 1024 + pn * 256)) * 512 * 2;
        u.pm = pm; u.pn = pn; u.aux = br; return true;
    } else {
        const int ntile = ((l == DEPTH - 1) ? TL / 256 : TC / 256) * 4;
        const int ti = i * G + c; if (ti >= ntile) return false;
        const int pm = ti >> 2, pn = ti & 3;
        u.A = ws + OFF_M + (size_t)pm * 256 * 1024 * 2; u.B = ws + OFF_WOUT + ((size_t)(l * 1024 + pn * 256)) * 1024 * 2;
        u.pm = pm; u.pn = pn; u.aux = 0; return true;
    }
}

__device__ __forceinline__ void epilogue(const Params& p, const int kind, const int l, const int ch, const Unit& u, f32x4 (&acc)[2][2][4][2], int wr, int wc, int fr, int fq) {
    unsigned char* ws = p.ws;
    const int cw = wc * 32 + 8 * fq, rl0 = wr * 64 + fr;
    const int pm = u.pm, pn = u.pn;
    if (kind == K_IN) {
        const float* bias = (const float*)(ws + OFF_BIN) + (size_t)l * NIN + pn * 256;
        if (pn < 8) {
            f32x4 b[2][2];
#pragma unroll
            for (int bj = 0; bj < 2; ++bj)
#pragma unroll
                for (int n = 0; n < 2; ++n) b[bj][n] = *(const f32x4*)(bias + 128 * bj + cw + 4 * n);
            h16* dst = (h16*)(ws + (pn < 4 ? OFF_CX : OFF_BZ)) + (size_t)(pm * 256 + rl0) * 512 + 128 * (pn & 3) + cw;
            const bool mul = pn < 4;
#pragma unroll
            for (int ai = 0; ai < 2; ++ai)
#pragma unroll
                for (int m = 0; m < 4; ++m) {
                    h8 o;
#pragma unroll
                    for (int n = 0; n < 2; ++n)
#pragma unroll
                        for (int j = 0; j < 4; ++j) {
                            const float v0 = acc[ai][0][m][n][j] + b[0][n][j], v1 = acc[ai][1][m][n][j] + b[1][n][j];
                            o[4 * n + j] = (h16)(mul ? v0 * v1 : v0 * silu_f(v1));
                        }
                    *(h8*)(dst + (size_t)(128 * ai + 16 * m) * 512) = o;
                }
        } else if (pn < 28) {
            f32x4 b[2][2];
#pragma unroll
            for (int bj = 0; bj < 2; ++bj)
#pragma unroll
                for (int n = 0; n < 2; ++n) b[bj][n] = *(const f32x4*)(bias + 128 * bj + cw + 4 * n);
            size_t off; int ld, oc, act;
            if (pn < 10) { off = OFF_FZ; ld = 512; oc = (pn - 8) * 256; act = 1; }
            else if (pn < 12) { off = OFF_Q; ld = 512; oc = (pn - 10) * 256; act = 3; }
            else if (pn < 14) { off = OFF_K; ld = 512; oc = (pn - 12) * 256; act = 0; }
            else if (pn < 16) { off = OFF_CZ; ld = 512; oc = (pn - 14) * 256; act = 1; }
            else { off = OFF_G; ld = 3072; oc = (pn - 16) * 256; act = 2; }
            h16* dst = (h16*)(ws + off) + (size_t)(pm * 256 + rl0) * ld + oc + cw;
            const bool isk = (pn == 12 || pn == 13);
#pragma unroll
            for (int ai = 0; ai < 2; ++ai)
#pragma unroll
                for (int m = 0; m < 4; ++m)
#pragma unroll
                    for (int bj = 0; bj < 2; ++bj) {
                        h8 o;
#pragma unroll
                        for (int n = 0; n < 2; ++n)
#pragma unroll
                            for (int j = 0; j < 4; ++j) {
                                float v = acc[ai][bj][m][n][j] + b[bj][n][j];
                                if (act == 1) v = silu_f(v); else if (act == 2) v = fmaxf(sigm_f(v), 6.2e-5f); else if (act == 3) v *= 0.125f;
                                o[4 * n + j] = (h16)v;
                            }
                        h16* q = dst + (size_t)(128 * ai + 16 * m) * ld + 128 * bj;
                        if (isk) {
                            const int tok = pm * 256 + 128 * ai + 16 * m + rl0, col = (pn - 12) * 256 + 128 * bj + cw;
                            q = (h16*)(ws + OFF_K) + ((size_t)((tok >> 3) * 8 + (col >> 6)) * 8 + ((col & 63) >> 3)) * 64 + (tok & 7) * 8;
                        }
                        *(h8*)q = o;
                    }
        } else {
            const bool lat = pm < TL / 256;
            const int bb = lat ? (pm >> 4) : (pm - TL / 256), pos0 = lat ? (pm & 15) * 256 : 0;
            if (pn < 30) {
                h16* VF = (h16*)(ws + OFF_VF);
#pragma unroll
                for (int ai = 0; ai < 2; ++ai)
#pragma unroll
                    for (int m = 0; m < 4; ++m) {
                        const int rt = 128 * ai + 16 * m + rl0, chn = (pn - 28) * 256 + rt;
                        const float bv = bias[rt];
#pragma unroll
                        for (int bj = 0; bj < 2; ++bj) {
                            const int t8 = (pm * 256 + 128 * bj + cw) >> 3;
                            h16* q = VF + ((size_t)(t8 * 8 + (chn >> 6)) * 4 + ((chn & 63) >> 4)) * 128 + (chn & 15) * 4;
                            h4 o0, o1;
#pragma unroll
                            for (int j = 0; j < 4; ++j) { o0[j] = (h16)(acc[ai][bj][m][0][j] + bv); o1[j] = (h16)(acc[ai][bj][m][1][j] + bv); }
                            *(h4*)q = o0; *(h4*)(q + 64) = o1;
                        }
                    }
            } else {
                h16* dst; int ld;
                const int part = (pn - 30) >> 1, c0 = ((pn - 30) & 1) * 256;
                if (lat) { dst = (h16*)(ws + OFF_VTL) + ((size_t)(bb * 512 + c0)) * 8192 + part * 4096 + pos0; ld = 8192; }
                else { dst = (h16*)(ws + OFF_VTC) + ((size_t)(bb * 512 + c0)) * 512 + part * 256; ld = 512; }
#pragma unroll
                for (int ai = 0; ai < 2; ++ai)
#pragma unroll
                    for (int m = 0; m < 4; ++m) {
                        const int rt = 128 * ai + 16 * m + rl0;
                        const float bv = bias[rt];
#pragma unroll
                        for (int bj = 0; bj < 2; ++bj) {
                            h8 o;
#pragma unroll
                            for (int n = 0; n < 2; ++n)
#pragma unroll
                                for (int j = 0; j < 4; ++j) o[4 * n + j] = (h16)(acc[ai][bj][m][n][j] + bv);
                            *(h8*)(dst + (size_t)rt * ld + 128 * bj + cw) = o;
                        }
                    }
            }
        }
    } else if (kind == K_DFT || kind == K_CDFT) {
        const float sc = (kind == K_DFT) ? (1.f / 64.f) : (1.f / 16.f);
        const int rstride = (kind == K_DFT) ? 16 : 1;
        const int row0 = (kind == K_DFT) ? (u.aux * 4096 + (pn >> 1)) : (TL + u.aux * 256);
        const int colb = (kind == K_DFT) ? ((pn & 1) * 256) : (pn * 256);
        h16* dst = (h16*)(ws + OFF_FZ) + (size_t)(row0 + rl0 * rstride) * 512 + colb + cw;
#pragma unroll
        for (int ai = 0; ai < 2; ++ai) {
            h8 fz[4][2];
#pragma unroll
            for (int m = 0; m < 4; ++m)
#pragma unroll
                for (int bj = 0; bj < 2; ++bj) fz[m][bj] = *(const h8*)(dst + (size_t)((128 * ai + 16 * m) * rstride) * 512 + 128 * bj);
#pragma unroll
            for (int m = 0; m < 4; ++m)
#pragma unroll
                for (int bj = 0; bj < 2; ++bj) {
                    h16* q = dst + (size_t)((128 * ai + 16 * m) * rstride) * 512 + 128 * bj; h8 o;
#pragma unroll
                    for (int n = 0; n < 2; ++n)
#pragma unroll
                        for (int j = 0; j < 4; ++j) o[4 * n + j] = (h16)(acc[ai][bj][m][n][j] * sc * (float)fz[m][bj][4 * n + j]);
                    *(h8*)q = o;
                }
            asm volatile("" ::: "memory");
        }
    } else if (kind == K_MERGE) {
        const int br = u.aux;
        const h16* gp = (const h16*)(ws + OFF_G) + (size_t)(pm * 256 + rl0) * 3072 + br * 1024 + pn * 256 + cw;
        h16* mp = (h16*)(ws + OFF_M) + (size_t)(pm * 256 + rl0) * 1024 + pn * 256 + cw;
#pragma unroll
        for (int ai = 0; ai < 2; ++ai) {
            h8 ga[4][2], gb[4][2];
#pragma unroll
            for (int m = 0; m < 4; ++m)
#pragma unroll
                for (int bj = 0; bj < 2; ++bj) {
                    const h16* q = gp + (size_t)(128 * ai + 16 * m) * 3072 + 128 * bj;
                    ga[m][bj] = *(const h8*)q;
                    if (br < 2) gb[m][bj] = *(const h8*)(q + 1024);
                }
#pragma unroll
            for (int m = 0; m < 4; ++m)
#pragma unroll
                for (int bj = 0; bj < 2; ++bj) {
                    if (br < 2) {
#pragma unroll
                        for (int n = 0; n < 2; ++n)
#pragma unroll
                            for (int j = 0; j < 4; ++j) acc[ai][bj][m][n][j] *= (float)ga[m][bj][4 * n + j] * __builtin_amdgcn_rcpf((float)gb[m][bj][4 * n + j]);
                    } else {
                        h8 o;
#pragma unroll
                        for (int n = 0; n < 2; ++n)
#pragma unroll
                            for (int j = 0; j < 4; ++j) o[4 * n + j] = (h16)(acc[ai][bj][m][n][j] * (float)ga[m][bj][4 * n + j]);
                        *(h8*)(mp + (size_t)(128 * ai + 16 * m) * 1024 + 128 * bj) = o;
                    }
                }
            asm volatile("" ::: "memory");
        }
    } else {
        const bool lat = pm < TL / 256;
        const float* res; float* dst; const float* gt;
        const float* MOD = (const float*)(ws + OFF_MOD) + (size_t)l * 17 * 3072 + 2048;
        if (lat) {
            const size_t t0 = ((size_t)ch * TL + pm * 256) * 1024;
            res = ((l == 0) ? p.x : p.out) + t0; dst = p.out + t0; gt = MOD + (size_t)(ch * BC + (pm >> 4)) * 3072;
        } else {
            const size_t t0 = ((size_t)ch * TX + (pm - TL / 256) * 256) * 1024;
            res = ((l == 0) ? p.ctx : (const float*)(ws + OFF_CTXR)) + t0; dst = (float*)(ws + OFF_CTXR) + t0; gt = MOD + (size_t)16 * 3072;
        }
        const int c0 = pn * 256 + cw;
        f32x4 gv[2][2];
#pragma unroll
        for (int bj = 0; bj < 2; ++bj)
#pragma unroll
            for (int n = 0; n < 2; ++n) gv[bj][n] = *(const f32x4*)(gt + c0 + 128 * bj + 4 * n);
#pragma unroll
        for (int ai = 0; ai < 2; ++ai) {
            f32x4 r[4][2][2];
#pragma unroll
            for (int m = 0; m < 4; ++m)
#pragma unroll
                for (int bj = 0; bj < 2; ++bj)
#pragma unroll
                    for (int n = 0; n < 2; ++n) r[m][bj][n] = *(const f32x4*)(res + (size_t)(128 * ai + 16 * m + rl0) * 1024 + c0 + 128 * bj + 4 * n);
#pragma unroll
            for (int m = 0; m < 4; ++m)
#pragma unroll
                for (int bj = 0; bj < 2; ++bj)
#pragma unroll
                    for (int n = 0; n < 2; ++n) *(f32x4*)(dst + (size_t)(128 * ai + 16 * m + rl0) * 1024 + c0 + 128 * bj + 4 * n) = r[m][bj][n] + gv[bj][n] * acc[ai][bj][m][n];
            asm volatile("" ::: "memory");
        }
    }
}

__device__ __forceinline__ void gemm_phase(const Params& p, LAS unsigned char* lds, const int kind, const int l, const int ch, const int K, const int tid, const int bid) {
    const int wid = __builtin_amdgcn_readfirstlane(tid >> 6), lane = tid & 63, wr = wid >> 2, wc = wid & 3, fr = lane & 15, fq = lane >> 4;
    const int nt = K / BK;
    unsigned voffA[2], voffB[2];
#pragma unroll
    for (int i = 0; i < 2; ++i) { int R, C; stage_rc(tid * 16 + i * 8192, R, C); const int Rb = (R & ~31) + perm32(R & 31);
        voffA[i] = (unsigned)(R * K + C) * 2u; voffB[i] = (unsigned)(Rb * K + C) * 2u; }
    const size_t kstep = (size_t)(BK * 2);
    const size_t hstep = (size_t)HALF * K * 2;
    const unsigned ldsw = (unsigned)wid * 1024u;
    const int aoff = lds_byte(wr * 64 + fr, fq * 8), boff = lds_byte(wc * 32 + fr, fq * 8);
#define PG8_SA(b, h) (((b) * 2 + (h)) * HTB)
#define PG8_SB(b, h) ((4 + (b) * 2 + (h)) * HTB)
#define PG8_STAGE(bufoff, gbase, voff) do { _Pragma("unroll") for (int _i = 0; _i < 2; ++_i) \
        __builtin_amdgcn_global_load_lds((const unsigned*)((const char*)(gbase) + (voff)[_i]), (LAS unsigned*)(lds + (bufoff) + ldsw + _i * 8192), 16, 0, 0); } while (0)
#define PG8_LDA(dst, b, h) do { _Pragma("unroll") for (int m = 0; m < 4; ++m) _Pragma("unroll") for (int k = 0; k < 2; ++k) dst[m][k] = *(const LAS h8*)(lds + PG8_SA(b, h) + aoff + m * 2048 + k * 1024); } while (0)
#define PG8_LDB(dst, b, h) do { _Pragma("unroll") for (int n = 0; n < 2; ++n) _Pragma("unroll") for (int k = 0; k < 2; ++k) dst[n][k] = *(const LAS h8*)(lds + PG8_SB(b, h) + boff + n * 2048 + k * 1024); } while (0)
#define PG8_MMA(ai, bj, At, Bt) do { __builtin_amdgcn_s_setprio(1); _Pragma("unroll") for (int m = 0; m < 4; ++m) _Pragma("unroll") for (int n = 0; n < 2; ++n) _Pragma("unroll") for (int k = 0; k < 2; ++k) \
        acc[ai][bj][m][n] = __builtin_amdgcn_mfma_f32_16x16x32_f16(Bt[n][k], At[m][k], acc[ai][bj][m][n], 0, 0, 0); __builtin_amdgcn_s_setprio(0); } while (0)
#define PG8_WAIT_V(n) asm volatile("s_waitcnt vmcnt(" #n ")" ::: "memory")
#define PG8_WAIT_L(n) asm volatile("s_waitcnt lgkmcnt(" #n ")" ::: "memory")
#define PG8_BAR __builtin_amdgcn_s_barrier()
#define PG8_SCHED __builtin_amdgcn_sched_barrier(0)
    Unit cur, nxt; int ui = 0;
    if (!sched_next(p, kind, l, 0, cur, bid)) return;
    f32x4 acc[2][2][4][2];
#pragma unroll
    for (int a = 0; a < 2; ++a)
#pragma unroll
        for (int b = 0; b < 2; ++b)
#pragma unroll
            for (int m = 0; m < 4; ++m)
#pragma unroll
                for (int n = 0; n < 2; ++n) acc[a][b][m][n] = (f32x4){0.f, 0.f, 0.f, 0.f};
    h8 At[4][2], B0[2][2], B1[2][2];
    const char* cA = cur.A; const char* cB = cur.B;
    PG8_STAGE(PG8_SB(0, 0), cB, voffB); PG8_STAGE(PG8_SA(0, 0), cA, voffA); PG8_STAGE(PG8_SB(0, 1), cB + hstep, voffB); PG8_STAGE(PG8_SA(0, 1), cA + hstep, voffA);
    if (wr == 1) PG8_BAR;
    PG8_WAIT_V(4); PG8_BAR;
    PG8_STAGE(PG8_SB(1, 0), cB + kstep, voffB); PG8_STAGE(PG8_SA(1, 0), cA + kstep, voffA); PG8_STAGE(PG8_SB(1, 1), cB + hstep + kstep, voffB);
    PG8_WAIT_V(6); PG8_BAR;
    for (;;) {
        const bool has_next = sched_next(p, kind, l, ui + 1, nxt, bid);
        const char* nA = has_next ? nxt.A : cA; const char* nB = has_next ? nxt.B : cB;
        for (int t = 0; t < nt; t += 2) {
            const bool last = (t == nt - 2);
            const char* a1 = cA + (size_t)(t + 1) * kstep;
            const char* a2 = last ? nA : cA + (size_t)(t + 2) * kstep; const char* b2 = last ? nB : cB + (size_t)(t + 2) * kstep;
            const char* a3 = a2 + kstep; const char* b3 = b2 + kstep;
            PG8_LDB(B0, 0, 0); PG8_SCHED; PG8_LDA(At, 0, 0); PG8_STAGE(PG8_SA(1, 1), a1 + hstep, voffA);
            PG8_WAIT_L(8); PG8_BAR; PG8_WAIT_L(0); PG8_MMA(0, 0, At, B0); PG8_BAR; PG8_SCHED;
            PG8_LDB(B1, 0, 1); PG8_STAGE(PG8_SB(0, 0), b2, voffB);
            PG8_BAR; PG8_WAIT_L(0); PG8_MMA(0, 1, At, B1); PG8_BAR;
            PG8_LDA(At, 0, 1); PG8_STAGE(PG8_SA(0, 0), a2, voffA);
            PG8_BAR; PG8_WAIT_L(0); PG8_MMA(1, 0, At, B0); PG8_BAR; PG8_SCHED;
            PG8_STAGE(PG8_SB(0, 1), b2 + hstep, voffB);
            PG8_WAIT_V(6); PG8_BAR; PG8_MMA(1, 1, At, B1); PG8_BAR;
            PG8_LDB(B0, 1, 0); PG8_SCHED; PG8_LDA(At, 1, 0); PG8_STAGE(PG8_SA(0, 1), a2 + hstep, voffA);
            PG8_WAIT_L(8); PG8_BAR; PG8_WAIT_L(0); PG8_MMA(0, 0, At, B0); PG8_BAR; PG8_SCHED;
            PG8_LDB(B1, 1, 1); PG8_STAGE(PG8_SB(1, 0), b3, voffB);
            PG8_BAR; PG8_WAIT_L(0); PG8_MMA(0, 1, At, B1); PG8_BAR;
            PG8_LDA(At, 1, 1); PG8_STAGE(PG8_SA(1, 0), a3, voffA);
            PG8_BAR; PG8_WAIT_L(0); PG8_MMA(1, 0, At, B0); PG8_BAR; PG8_SCHED;
            PG8_STAGE(PG8_SB(1, 1), b3 + hstep, voffB);
            PG8_WAIT_V(6); PG8_BAR; PG8_MMA(1, 1, At, B1); PG8_BAR;
        }
        epilogue(p, kind, l, ch, cur, acc, wr, wc, fr, fq);
        if (!has_next) break;
        if (kind != K_MERGE || cur.aux == 2)
#pragma unroll
        for (int a = 0; a < 2; ++a)
#pragma unroll
            for (int b = 0; b < 2; ++b)
#pragma unroll
                for (int m = 0; m < 4; ++m)
#pragma unroll
                    for (int n = 0; n < 2; ++n) acc[a][b][m][n] = (f32x4){0.f, 0.f, 0.f, 0.f};
        cur = nxt; cA = nA; cB = nB; ++ui;
    }
    PG8_WAIT_V(0);
    if (wr == 0) PG8_BAR;
    PG8_BAR;
#undef PG8_SA
#undef PG8_SB
#undef PG8_STAGE
#undef PG8_LDA
#undef PG8_LDB
#undef PG8_MMA
#undef PG8_WAIT_V
#undef PG8_WAIT_L
#undef PG8_BAR
#undef PG8_SCHED
}

constexpr int N_PHASES = 1 + DEPTH * NCH * 6 + 1;

__global__ void __launch_bounds__(NTHREADS, 2) fwd_megakernel(Params p) {
    extern __shared__ __attribute__((aligned(16))) unsigned char lds_raw[];
    LAS unsigned char* lds = (LAS unsigned char*)lds_raw;
    cg::grid_group grid = cg::this_grid();
    const int wv0 = __builtin_amdgcn_readfirstlane(threadIdx.x >> 6);
    for (int ph = p.ph_lo; ph < p.ph_hi; ++ph) {
        int wvq = wv0; asm volatile("" : "+s"(wvq));
        int lnq; asm volatile("v_mbcnt_lo_u32_b32 %0, -1, 0\n\tv_mbcnt_hi_u32_b32 %0, -1, %0" : "=v"(lnq));
        int tid = (wvq << 6) | lnq, bid = blockIdx.x;
#define LAUNDER() do { asm volatile("" : "+v"(tid)); asm volatile("" : "+s"(bid)); } while (0)
        LAUNDER();
        if (ph == 0) {
            if (blockIdx.x == 0 && threadIdx.x == 0) __hip_atomic_store((unsigned*)(p.ws + OFF_BAR), 0u, __ATOMIC_RELAXED, __HIP_MEMORY_SCOPE_AGENT);
            for (int rep = 0; rep < 1 + REP_P0; ++rep) { LAUNDER(); p0_prologue(p, lds, tid, bid); }
        } else if (ph == N_PHASES - 1) {
            pf_final(p, tid, bid);
        } else {
            const int q = ph - 1, s = q % 6, lc = q / 6, ch = lc % NCH, l = lc / NCH;
            if (s == 0) p1_norm(p, l, ch, tid, bid);
            else if (s == 1) { for (int rep = 0; rep < 1 + REP_P2; ++rep) { LAUNDER(); gemm_phase(p, lds, K_IN, l, ch, 1024, tid, bid); } }
            else if (s == 2) {
                p3_dft1(p, tid, bid);
                if (l < DEPTH - 1) gemm_phase(p, lds, K_CDFT, l, ch, 512, tid, bid);
                p3_conv(p, l, tid, bid);
                p3_attn(p, l, (LAS float*)(lds + LDS_STAGE), tid, bid, false);
            }
            else if (s == 3) gemm_phase(p, lds, K_DFT, l, ch, 512, tid, bid);
            else if (s == 4) { for (int rep = 0; rep < 1 + REP_P4; ++rep) { LAUNDER(); gemm_phase(p, lds, K_MERGE, l, ch, 512, tid, bid); } }
            else gemm_phase(p, lds, K_OUT, l, ch, 1024, tid, bid);
        }
        if (ph + 1 < p.ph_hi) {
            if (ph == 0) grid.sync();
            else {
                __syncthreads();
                if (threadIdx.x == 0) {
                    unsigned* ctr = (unsigned*)(p.ws + OFF_BAR);
                    const unsigned target = (unsigned)ph * gridDim.x;
                    __builtin_amdgcn_fence(__ATOMIC_RELEASE, "agent");
                    asm volatile("s_waitcnt vmcnt(0) lgkmcnt(0)" ::: "memory");
                    __hip_atomic_fetch_add(ctr, 1u, __ATOMIC_RELAXED, __HIP_MEMORY_SCOPE_AGENT);
                    while (__hip_atomic_load(ctr, __ATOMIC_RELAXED, __HIP_MEMORY_SCOPE_AGENT) < target) __builtin_amdgcn_s_sleep(1);
                    __builtin_amdgcn_fence(__ATOMIC_ACQUIRE, "agent");
                    asm volatile("s_waitcnt vmcnt(0) lgkmcnt(0)" ::: "memory");
                }
                __syncthreads();
            }
        }
    }
}

extern "C" void kernel_launch(void* const* d_in, const int* in_sizes, int n_in, void* d_out, int out_size, void* d_ws, size_t ws_size, hipStream_t stream) {
    static int grid_blocks = 0;
    if (!grid_blocks) {
        int dev = 0, cus = 0, per_cu = 0;
        hipGetDevice(&dev);
        hipDeviceGetAttribute(&cus, hipDeviceAttributeMultiprocessorCount, dev);
        if (hipFuncSetAttribute((const void*)fwd_megakernel, hipFuncAttributeMaxDynamicSharedMemorySize, LDS_BYTES) != hipSuccess) fprintf(stderr, "kernel_launch: hipFuncSetAttribute failed\n");
        hipOccupancyMaxActiveBlocksPerMultiprocessor(&per_cu, (const void*)fwd_megakernel, NTHREADS, LDS_BYTES);
        if (per_cu < 1) { fprintf(stderr, "kernel_launch: occupancy query says %d blocks/CU\n", per_cu); per_cu = 1; }
        (void)hipGetLastError();
        grid_blocks = cus * per_cu;
        if (ws_size < WS_END) fprintf(stderr, "kernel_launch: workspace too small: %zu < %zu\n", ws_size, (size_t)WS_END);
    }
    Params p{};
    const float** f = (const float**)&p;
    for (int i = 0; i < 17; ++i) f[i] = (const float*)d_in[i];
    p.out = (float*)d_out; p.ws = (unsigned char*)d_ws;
#if MULTI_LAUNCH
    for (int ph = 0; ph < N_PHASES; ++ph) {
        p.ph_lo = ph; p.ph_hi = ph + 1;
        hipLaunchKernelGGL(fwd_megakernel, dim3(grid_blocks), dim3(NTHREADS), LDS_BYTES, stream, p);
    }
#else
    p.ph_lo = 0; p.ph_hi = N_PHASES;
    void* args[] = {&p};
    hipError_t e = hipLaunchCooperativeKernel((const void*)fwd_megakernel, dim3(grid_blocks), dim3(NTHREADS), args, LDS_BYTES, stream);
    if (e != hipSuccess) fprintf(stderr, "cooperative launch failed: %s (grid %d)\n", hipGetErrorString(e), grid_blocks);
#endif
}
```
